# Optimizing an MI355X kernel written in HIP

```python
import math
import jax, jax.numpy as jnp
from jax import lax
import numpy as np

D_MODEL = 1024
BATCH = 2
SEQ = 8192
DEPTH = 1
DEC_BATCH = 128
DEC_SEQ = 1
PAST_LEN = 16384
PAGE_SIZE = 128

ATTN_HEADS = 8
KV_HEADS = 2
HEAD_DIM = 64
GQA_GROUP = ATTN_HEADS // KV_HEADS
ATTN_WIDTH = ATTN_HEADS * HEAD_DIM
KV_WIDTH = KV_HEADS * HEAD_DIM
WINDOW = 128
BLOCK = WINDOW
GDN_HEADS = 4
GDN_DK = 128
GDN_DV = 128
GDN_KEY_WIDTH = GDN_HEADS * GDN_DK
GDN_VAL_WIDTH = GDN_HEADS * GDN_DV
GDN_CONV_DIM = 2 * GDN_KEY_WIDTH + GDN_VAL_WIDTH
CONV_W = 4
CHUNK = 64
MIX_WIDTH = ATTN_WIDTH + GDN_VAL_WIDTH
IN_WIDTH = ATTN_WIDTH + 2 * KV_WIDTH + GDN_CONV_DIM + GDN_VAL_WIDTH + 2 * GDN_HEADS
D_FF = 4 * D_MODEL
EPS = 1e-6

kernel_name = 'hymba_swa_sink_alibi_gated_deltanet_step'


def _split_points():
    sizes = (ATTN_WIDTH, KV_WIDTH, KV_WIDTH, GDN_CONV_DIM, GDN_VAL_WIDTH, GDN_HEADS, GDN_HEADS)
    pts, acc = [], 0
    for s in sizes[:-1]:
        acc += s
        pts.append(acc)
    return pts


def rms_norm(x, w):
    xf = x.astype(jnp.float32)
    y = xf * lax.rsqrt(jnp.mean(xf * xf, axis=-1, keepdims=True) + EPS)
    return (y * w.astype(jnp.float32)).astype(x.dtype)


def l2_norm(x):
    return x * lax.rsqrt(jnp.sum(x * x, axis=-1, keepdims=True) + EPS)


def alibi_slopes():
    return jnp.exp2(-8.0 * jnp.arange(1, ATTN_HEADS + 1, dtype=jnp.float32) / ATTN_HEADS)


def window_attend(q, k, v, dist, valid, sinks):
    scores = jnp.einsum('...qkgd,...skd->...kgqs', q, k).astype(jnp.float32) * (HEAD_DIM ** -0.5)
    slopes = alibi_slopes().reshape(KV_HEADS, GQA_GROUP, 1, 1)
    scores = scores - slopes * dist.astype(jnp.float32)
    scores = jnp.where(valid, scores, -jnp.inf)
    sink = jnp.broadcast_to(sinks.astype(jnp.float32).reshape(KV_HEADS, GQA_GROUP, 1, 1),
                            scores.shape[:-1] + (1,))
    probs = jax.nn.softmax(jnp.concatenate([scores, sink], axis=-1), axis=-1)[..., :-1]
    return jnp.einsum('...kgqs,...skd->...qkgd', probs.astype(v.dtype), v)


def attn_prompt(q, k, v, sinks):
    Bn, L = q.shape[:2]
    nb = L // BLOCK
    qb = q.reshape(Bn, nb, BLOCK, KV_HEADS, GQA_GROUP, HEAD_DIM)

    def with_prev(x):
        xb = x.reshape(Bn, nb, BLOCK, KV_HEADS, HEAD_DIM)
        prev = jnp.concatenate([jnp.zeros_like(xb[:, :1]), xb[:, :-1]], axis=1)
        return jnp.concatenate([prev, xb], axis=2)

    qi = jnp.arange(BLOCK)[:, None]
    si = jnp.arange(2 * BLOCK)[None, :]
    dist = BLOCK + qi - si
    band = (dist >= 0) & (dist <= WINDOW)
    in_seq = (jnp.arange(nb)[:, None, None] > 0) | (si >= BLOCK)[None]
    valid = (band[None] & in_seq).reshape(nb, 1, 1, BLOCK, 2 * BLOCK)
    out = window_attend(qb, with_prev(k), with_prev(v), dist, valid, sinks)
    return out.reshape(Bn, L, ATTN_WIDTH)


def attn_sample(q, k_new, v_new, k_buf, v_buf, sinks):
    DB, T = q.shape[:2]
    keys = jnp.concatenate([k_buf.astype(k_new.dtype), k_new], axis=1)
    vals = jnp.concatenate([v_buf.astype(v_new.dtype), v_new], axis=1)
    qi = jnp.arange(T)[:, None]
    sj = jnp.arange(WINDOW + T)[None, :]
    dist = WINDOW + qi - sj
    valid = (dist >= 0) & (dist <= WINDOW)
    out = window_attend(q.reshape(DB, T, KV_HEADS, GQA_GROUP, HEAD_DIM), keys, vals, dist, valid, sinks)
    return out.reshape(DB, T, ATTN_WIDTH), keys[:, -WINDOW:], vals[:, -WINDOW:]


def causal_conv(ext, w):
    L = ext.shape[1] - (CONV_W - 1)
    w = w.astype(ext.dtype)
    y = ext[:, 0:L] * w[0]
    for i in range(1, CONV_W):
        y = y + ext[:, i:i + L] * w[i]
    return jax.nn.silu(y)


def gdn_prep(qkv, a, b, a_log, dt_bias):
    Bn, L = qkv.shape[:2]
    qkv = qkv.astype(jnp.float32)
    q, k, v = jnp.split(qkv, [GDN_KEY_WIDTH, 2 * GDN_KEY_WIDTH], axis=-1)
    q = l2_norm(q.reshape(Bn, L, GDN_HEADS, GDN_DK)) * (GDN_DK ** -0.5)
    k = l2_norm(k.reshape(Bn, L, GDN_HEADS, GDN_DK))
    v = v.reshape(Bn, L, GDN_HEADS, GDN_DV)
    g = -jnp.exp(a_log.astype(jnp.float32)) * jax.nn.softplus(a.astype(jnp.float32) + dt_bias.astype(jnp.float32))
    beta = jax.nn.sigmoid(b.astype(jnp.float32))
    return q, k, v, g, beta


def gdn_chunked(q, k, v, g, beta):
    Bn, L, H, dk = q.shape
    dv = v.shape[-1]
    N = L // CHUNK

    def to_chunks(x):
        x = x.reshape((Bn, N, CHUNK, H) + x.shape[3:])
        return jnp.moveaxis(x, (1, 3), (0, 2))

    qc, kc, vc, gc, bc = (to_chunks(t) for t in (q, k, v, g, beta))
    G = jnp.cumsum(gc, axis=-1)
    idx = jnp.arange(CHUNK)
    lower_incl = idx[:, None] >= idx[None, :]
    lower_strict = idx[:, None] > idx[None, :]
    diff = G[..., :, None] - G[..., None, :]
    decay = jnp.where(lower_incl, jnp.exp(jnp.where(lower_incl, diff, 0.0)), 0.0)
    kk = jnp.einsum('nbhid,nbhjd->nbhij', kc, kc)
    A = jnp.where(lower_strict, bc[..., :, None] * kk * decay, 0.0)
    eye = jnp.eye(CHUNK, dtype=jnp.float32)
    Tinv = lax.linalg.triangular_solve(eye + A, jnp.broadcast_to(eye, A.shape), left_side=True, lower=True)
    u_base = jnp.einsum('nbhij,nbhjd->nbhid', Tinv, vc * bc[..., None])
    w = jnp.einsum('nbhij,nbhjd->nbhid', Tinv, kc * (bc * jnp.exp(G))[..., None])
    qk = jnp.where(lower_incl, jnp.einsum('nbhid,nbhjd->nbhij', qc, kc) * decay, 0.0)
    q_dec = qc * jnp.exp(G)[..., None]
    k_dec = kc * jnp.exp(G[..., -1:] - G)[..., None]
    last_decay = jnp.exp(G[..., -1])

    def step(S, xs):
        u_b, w_c, qk_c, q_d, k_d, ld = xs
        u = u_b - jnp.einsum('bhcd,bhde->bhce', w_c, S)
        o = jnp.einsum('bhcd,bhde->bhce', q_d, S) + jnp.einsum('bhij,bhje->bhie', qk_c, u)
        S = S * ld[..., None, None] + jnp.einsum('bhcd,bhce->bhde', k_d, u)
        return S, o

    S0 = jnp.zeros((Bn, H, dk, dv), jnp.float32)
    S_fin, o = lax.scan(step, S0, (u_base, w, qk, q_dec, k_dec, last_decay))
    o = jnp.moveaxis(o, (0, 2), (1, 3)).reshape(Bn, L, H, dv)
    return o, S_fin


def gdn_recurrent(q, k, v, g, beta, S0):
    def step(S, xs):
        q_t, k_t, v_t, g_t, b_t = xs
        S = S * jnp.exp(g_t)[..., None, None]
        kv = jnp.einsum('bhd,bhde->bhe', k_t, S)
        u = (v_t - kv) * b_t[..., None]
        S = S + jnp.einsum('bhd,bhe->bhde', k_t, u)
        return S, jnp.einsum('bhd,bhde->bhe', q_t, S)

    xs = tuple(jnp.moveaxis(t, 1, 0) for t in (q, k, v, g, beta))
    S, o = lax.scan(step, S0.astype(jnp.float32), xs)
    return jnp.moveaxis(o, 0, 1), S


def mixer_in(x, lp):
    Bn, L = x.shape[:2]
    h = rms_norm(x, lp['norm_mix_pre'])
    proj = jnp.einsum('bld,de->ble', h, lp['w_in'].astype(h.dtype))
    q_a, k_a, v_a, qkv_g, z_g, a_g, b_g = jnp.split(proj, _split_points(), axis=-1)
    q_a = q_a.reshape(Bn, L, ATTN_HEADS, HEAD_DIM)
    k_a = k_a.reshape(Bn, L, KV_HEADS, HEAD_DIM)
    v_a = v_a.reshape(Bn, L, KV_HEADS, HEAD_DIM)
    return q_a, k_a, v_a, qkv_g, z_g, a_g, b_g


def mixer_out(x, attn_o, gdn_o, z, lp):
    Bn, L = x.shape[:2]
    gate = jax.nn.silu(z.astype(jnp.float32).reshape(Bn, L, GDN_HEADS, GDN_DV))
    gdn_y = rms_norm(gdn_o, lp['gdn_norm']) * gate
    mix = jnp.concatenate([attn_o.astype(x.dtype), gdn_y.reshape(Bn, L, GDN_VAL_WIDTH).astype(x.dtype)], axis=-1)
    x = x + rms_norm(jnp.einsum('blm,md->bld', mix, lp['w_out'].astype(x.dtype)), lp['norm_mix_post'])
    h = rms_norm(x, lp['norm_ffn_pre'])
    u = jax.nn.relu(jnp.einsum('bld,df->blf', h, lp['w_up'].astype(h.dtype)))
    f = jnp.einsum('blf,fd->bld', u * u, lp['w_down'].astype(h.dtype))
    return x + rms_norm(f, lp['norm_ffn_post'])


def prompt_layer(x, lp):
    q_a, k_a, v_a, qkv, z, a, b = mixer_in(x, lp)
    attn_o = attn_prompt(q_a, k_a, v_a, lp['attn_sinks'])
    ext = jnp.concatenate([jnp.zeros_like(qkv[:, :CONV_W - 1]), qkv], axis=1)
    q, k, v, g, beta = gdn_prep(causal_conv(ext, lp['conv_w']), a, b, lp['gdn_a_log'], lp['gdn_dt_bias'])
    gdn_o, S = gdn_chunked(q, k, v, g, beta)
    y = mixer_out(x, attn_o, gdn_o, z, lp)
    return y, ext[:, -(CONV_W - 1):], k_a[:, -WINDOW:], v_a[:, -WINDOW:], S


def sample_layer(x, conv_state, k_buf, v_buf, S0, lp):
    q_a, k_a, v_a, qkv, z, a, b = mixer_in(x, lp)
    attn_o, new_k, new_v = attn_sample(q_a, k_a, v_a, k_buf, v_buf, lp['attn_sinks'])
    ext = jnp.concatenate([conv_state.astype(qkv.dtype), qkv], axis=1)
    q, k, v, g, beta = gdn_prep(causal_conv(ext, lp['conv_w']), a, b, lp['gdn_a_log'], lp['gdn_dt_bias'])
    gdn_o, S = gdn_recurrent(q, k, v, g, beta, S0)
    y = mixer_out(x, attn_o, gdn_o, z, lp)
    return y, ext[:, -(CONV_W - 1):], new_k, new_v, S


def setup_inputs(seed: int = 0) -> dict:
    key = jax.random.key(seed)
    ks = jax.random.split(key, 24)
    f32 = jnp.float32

    def nrm(k, shape, scale):
        return jax.random.normal(k, shape, f32) * scale

    def gain(k, n):
        return 1.0 + 0.01 * jax.random.normal(k, (DEPTH, n), f32)

    dt = jnp.exp(jax.random.uniform(ks[10], (DEPTH, GDN_HEADS), f32, math.log(1e-3), math.log(0.1)))
    return {
        'x_prompt': nrm(ks[0], (BATCH, SEQ, D_MODEL), 1.0),
        'x_sample': nrm(ks[1], (DEC_BATCH, DEC_SEQ, D_MODEL), 1.0),
        'state_conv': nrm(ks[2], (DEPTH, DEC_BATCH, CONV_W - 1, GDN_CONV_DIM), 1.0),
        'cache_win_k': nrm(ks[3], (DEPTH, DEC_BATCH, WINDOW, KV_HEADS, HEAD_DIM), 1.0),
        'cache_win_v': nrm(ks[4], (DEPTH, DEC_BATCH, WINDOW, KV_HEADS, HEAD_DIM), 1.0),
        'state_gdn': nrm(ks[5], (DEPTH, DEC_BATCH, GDN_HEADS, GDN_DK, GDN_DV), GDN_DK ** -0.5),
        'norm_mix_pre': gain(ks[6], D_MODEL),
        'w_in': nrm(ks[7], (DEPTH, D_MODEL, IN_WIDTH), D_MODEL ** -0.5),
        'attn_sinks': nrm(ks[8], (DEPTH, ATTN_HEADS), 1.0),
        'conv_w': nrm(ks[9], (DEPTH, CONV_W, GDN_CONV_DIM), CONV_W ** -0.5),
        'gdn_a_log': jnp.log(jax.random.uniform(ks[11], (DEPTH, GDN_HEADS), f32, 1.0, 16.0)),
        'gdn_dt_bias': dt + jnp.log(-jnp.expm1(-dt)),
        'gdn_norm': gain(ks[12], GDN_DV),
        'w_out': nrm(ks[13], (DEPTH, MIX_WIDTH, D_MODEL), MIX_WIDTH ** -0.5),
        'norm_mix_post': gain(ks[14], D_MODEL),
        'norm_ffn_pre': gain(ks[15], D_MODEL),
        'w_up': nrm(ks[16], (DEPTH, D_MODEL, D_FF), D_MODEL ** -0.5),
        'w_down': nrm(ks[17], (DEPTH, D_FF, D_MODEL), D_FF ** -0.5),
        'norm_ffn_post': gain(ks[18], D_MODEL),
    }


def reference(x_prompt, x_sample, state_conv, cache_win_k, cache_win_v, state_gdn,
              norm_mix_pre, w_in, attn_sinks, conv_w, gdn_a_log, gdn_dt_bias, gdn_norm,
              w_out, norm_mix_post, norm_ffn_pre, w_up, w_down, norm_ffn_post):
    xp, xs = x_prompt, x_sample
    pc, pk, pv, ps = [], [], [], []
    sc, sk, sv, ss = [], [], [], []
    for l in range(DEPTH):
        lp = dict(norm_mix_pre=norm_mix_pre[l], w_in=w_in[l], attn_sinks=attn_sinks[l],
                  conv_w=conv_w[l], gdn_a_log=gdn_a_log[l], gdn_dt_bias=gdn_dt_bias[l],
                  gdn_norm=gdn_norm[l], w_out=w_out[l], norm_mix_post=norm_mix_post[l],
                  norm_ffn_pre=norm_ffn_pre[l], w_up=w_up[l], w_down=w_down[l],
                  norm_ffn_post=norm_ffn_post[l])
        xp, c1, k1, v1, s1 = prompt_layer(xp, lp)
        xs, c2, k2, v2, s2 = sample_layer(xs, state_conv[l], cache_win_k[l], cache_win_v[l], state_gdn[l], lp)
        pc.append(c1.astype(state_conv.dtype)); pk.append(k1.astype(cache_win_k.dtype))
        pv.append(v1.astype(cache_win_v.dtype)); ps.append(s1.astype(state_gdn.dtype))
        sc.append(c2.astype(state_conv.dtype)); sk.append(k2.astype(cache_win_k.dtype))
        sv.append(v2.astype(cache_win_v.dtype)); ss.append(s2.astype(state_gdn.dtype))
    p_state_conv = jnp.stack(pc)
    p_cache_win_k = jnp.stack(pk)
    p_cache_win_v = jnp.stack(pv)
    p_state_gdn = jnp.stack(ps)
    s_state_conv = jnp.stack(sc)
    s_cache_win_k = jnp.stack(sk)
    s_cache_win_v = jnp.stack(sv)
    s_state_gdn = jnp.stack(ss)
    return (xp, xs, p_state_conv, p_cache_win_k, p_cache_win_v, p_state_gdn,
            s_state_conv, s_cache_win_k, s_cache_win_v, s_state_gdn)
```

```cpp
#include <hip/hip_runtime.h>
#include <hip/hip_cooperative_groups.h>
#include <cstdio>
#include <cstdint>
namespace cg = cooperative_groups;
namespace pg8 {
#define PG8_LAS __attribute__((address_space(3)))
typedef unsigned short bf16_t;
typedef short bf16x8 __attribute__((ext_vector_type(8)));
typedef float f32x4 __attribute__((ext_vector_type(4)));
typedef unsigned u32x4 __attribute__((ext_vector_type(4)));
constexpr int BM = 256, BK = 64, HALF = 128, HTB = HALF * BK * 2  , STAGE_BYTES = 8 * HTB, NXCD = 8, WGM = 8;

__host__ __device__ __forceinline__ int lds_byte(int r, int c) { const int st = (r >> 4) * 2 + (c >> 5), rr = r & 15, cc = c & 31, ob = rr * 64 + cc * 2; return st * 1024 + (ob ^ (((ob >> 9) & 1) << 5)); }
__host__ __device__ __forceinline__ void stage_rc(int b, int& R, int& C) { const int st = b / 1024, sb = b % 1024, swz = sb ^ (((sb >> 9) & 1) << 5); R = (st >> 1) * 16 + swz / 64; C = (st & 1) * 32 + (swz % 64) / 2; }
__host__ __device__ __forceinline__ int perm32(int rho) { const int n = rho >> 4, i = rho & 15; return 8 * (i >> 2) + 4 * n + (i & 3); }

struct Unit { int pm, pn; };
struct Gemm { const bf16_t* A; const bf16_t* Bt; int M, N, K; };

struct StaticOrder {
    int nM, nN, nwg, G, c;
    __host__ __device__ void init(int M, int N, int G_, int c_) { nM = M / BM; nN = N / BM; nwg = nM * nN; G = G_; c = c_; }
    __host__ __device__ bool next(int i, Unit& u) const {
        const long L = (long)i * G + c; if (L >= nwg) return false;
        int wgid = (int)L; { const int q = nwg / NXCD, r = nwg % NXCD, xcd = wgid % NXCD, off = wgid / NXCD; wgid = (xcd < r ? xcd * (q + 1) : r * (q + 1) + (xcd - r) * q) + off; }
        const int nig = WGM * nN, gid = wgid / nig, fm = gid * WGM, gsz = (nM - fm) < WGM ? (nM - fm) : WGM;
        u.pm = fm + ((wgid % nig) % gsz); u.pn = (wgid % nig) / gsz; return true;
    }
    __device__ __forceinline__ void a_ready(const Unit&) const {}
    __device__ __forceinline__ void done(const Unit&) const {}
};

typedef unsigned u32x2e __attribute__((ext_vector_type(2)));
typedef __bf16 bf2e_t __attribute__((ext_vector_type(2)));
typedef float f32x2e __attribute__((ext_vector_type(2)));
__device__ __forceinline__ unsigned cvt_pk_bf16(float lo, float hi) { f32x2e v = {lo, hi}; return __builtin_bit_cast(unsigned, __builtin_convertvector(v, bf2e_t)); }
struct EpiInProj {
    static constexpr bool PERM = true, AFTER_DRAIN = false;
    bf16_t *QA, *KV, *QG, *Z;
    __device__ __forceinline__ void operator()(const f32x4 (&acc)[2][2][4][2], const Unit& u, int wr, int wc, int fr, int fq) const {
        const int pn = u.pn; bf16_t* base; int ldc, colt;
        if (pn < 2) { base = QA; ldc = 512; colt = pn * 256; } else if (pn == 2) { base = KV; ldc = 256; colt = 0; } else if (pn < 9) { base = QG; ldc = 1536; colt = (pn - 3) * 256; } else { base = Z; ldc = 512; colt = (pn - 9) * 256; }
        const int row0 = u.pm * BM + wr * 64 + fr, col0 = colt + wc * 32 + 8 * fq;
#pragma unroll
        for (int ai = 0; ai < 2; ++ai)
#pragma unroll
            for (int m = 0; m < 4; ++m) { bf16_t* rowp = base + (size_t)(row0 + ai * HALF + m * 16) * ldc + col0;
#pragma unroll
                for (int bj = 0; bj < 2; ++bj) { const f32x4 v0 = acc[ai][bj][m][0], v1 = acc[ai][bj][m][1];
                    u32x4 w; w.x = cvt_pk_bf16(v0[0], v0[1]); w.y = cvt_pk_bf16(v0[2], v0[3]); w.z = cvt_pk_bf16(v1[0], v1[1]); w.w = cvt_pk_bf16(v1[2], v1[3]);
                    *(u32x4*)(rowp + bj * HALF) = w; } }
    }
};
struct EpiRelu2 {
    static constexpr bool PERM = true, AFTER_DRAIN = false;
    bf16_t* O; int ldc;
    __device__ __forceinline__ void operator()(const f32x4 (&acc)[2][2][4][2], const Unit& u, int wr, int wc, int fr, int fq) const {
        const int row0 = u.pm * BM + wr * 64 + fr, col0 = u.pn * BM + wc * 32 + 8 * fq;
#pragma unroll
        for (int ai = 0; ai < 2; ++ai)
#pragma unroll
            for (int m = 0; m < 4; ++m) { bf16_t* rowp = O + (size_t)(row0 + ai * HALF + m * 16) * ldc + col0;
#pragma unroll
                for (int bj = 0; bj < 2; ++bj) { f32x4 v0 = acc[ai][bj][m][0], v1 = acc[ai][bj][m][1];
#pragma unroll
                    for (int e = 0; e < 4; ++e) { const float a = fmaxf(v0[e], 0.f), b = fmaxf(v1[e], 0.f); v0[e] = a * a; v1[e] = b * b; }
                    u32x4 w; w.x = cvt_pk_bf16(v0[0], v0[1]); w.y = cvt_pk_bf16(v0[2], v0[3]); w.z = cvt_pk_bf16(v1[0], v1[1]); w.w = cvt_pk_bf16(v1[2], v1[3]);
                    *(u32x4*)(rowp + bj * HALF) = w; } }
    }
};
struct EpiBf16p {
    static constexpr bool PERM = true, AFTER_DRAIN = false;
    bf16_t* O; int ldc;
    __device__ __forceinline__ void operator()(const f32x4 (&acc)[2][2][4][2], const Unit& u, int wr, int wc, int fr, int fq) const {
        const int row0 = u.pm * BM + wr * 64 + fr, col0 = u.pn * BM + wc * 32 + 8 * fq;
#pragma unroll
        for (int ai = 0; ai < 2; ++ai)
#pragma unroll
            for (int m = 0; m < 4; ++m) { bf16_t* rowp = O + (size_t)(row0 + ai * HALF + m * 16) * ldc + col0;
#pragma unroll
                for (int bj = 0; bj < 2; ++bj) { f32x4 v0 = acc[ai][bj][m][0], v1 = acc[ai][bj][m][1];
                    u32x4 w; w.x = cvt_pk_bf16(v0[0], v0[1]); w.y = cvt_pk_bf16(v0[2], v0[3]); w.z = cvt_pk_bf16(v1[0], v1[1]); w.w = cvt_pk_bf16(v1[2], v1[3]);
                    *(u32x4*)(rowp + bj * HALF) = w; } }
    }
};
struct EpiF32 {
    static constexpr bool PERM = true, AFTER_DRAIN = false;
    float* O; int ldc;
    __device__ __forceinline__ void operator()(const f32x4 (&acc)[2][2][4][2], const Unit& u, int wr, int wc, int fr, int fq) const {
        const int row0 = u.pm * BM + wr * 64 + fr, col0 = u.pn * BM + wc * 32 + 8 * fq;
#pragma unroll
        for (int ai = 0; ai < 2; ++ai)
#pragma unroll
            for (int m = 0; m < 4; ++m) { float* rowp = O + (size_t)(row0 + ai * HALF + m * 16) * ldc + col0;
#pragma unroll
                for (int bj = 0; bj < 2; ++bj) { *(f32x4*)(rowp + bj * HALF) = acc[ai][bj][m][0]; *(f32x4*)(rowp + bj * HALF + 4) = acc[ai][bj][m][1]; } }
    }
};
template <class Epi, class Sched, bool ALIGN_EPI = false, bool SP2 = false>
__device__ __forceinline__ void gemm_phase(PG8_LAS unsigned char* lds, const Gemm g, const Sched& S, const Epi& E) {
    int tid_ = threadIdx.x; asm volatile("" : "+v"(tid_));
    const int tid = tid_, wid = __builtin_amdgcn_readfirstlane(tid >> 6), lane = tid & 63, wr = wid >> 2, wc = wid & 3, fr = lane & 15, fq = lane >> 4;
    const int K = g.K, nt = K / BK;
    unsigned voffA[2], voffB[2];
#pragma unroll
    for (int i = 0; i < 2; ++i) { int R, C; stage_rc(tid * 16 + i * 8192, R, C); const int Rb = Epi::PERM ? ((R & ~31) + perm32(R & 31)) : R;
        voffA[i] = (unsigned)(R * K + C) * 2u; voffB[i] = (unsigned)(Rb * K + C) * 2u; }
    const size_t kstep = (size_t)(BK * 2);
    const size_t hstep = (size_t)HALF * K * 2;
    const size_t tstep = 2 * hstep;
    const unsigned ldsw = (unsigned)wid * 1024u;
    const int aoff = lds_byte(wr * 64 + fr, fq * 8), boff = lds_byte(wc * 32 + fr, fq * 8);
#define PG8_SA(b, h) (((b) * 2 + (h)) * HTB)
#define PG8_SB(b, h) ((4 + (b) * 2 + (h)) * HTB)
#define PG8_STAGE(bufoff, gbase, voff) do { _Pragma("unroll") for (int _i = 0; _i < 2; ++_i) \
        __builtin_amdgcn_global_load_lds((const unsigned*)((const char*)(gbase) + (voff)[_i]), (PG8_LAS unsigned*)(lds + (bufoff) + ldsw + _i * 8192), 16, 0, 0); } while (0)
#define PG8_LDA(dst, b, h) do { _Pragma("unroll") for (int m = 0; m < 4; ++m) _Pragma("unroll") for (int k = 0; k < 2; ++k) dst[m][k] = *(const PG8_LAS bf16x8*)(lds + PG8_SA(b, h) + aoff + m * 2048 + k * 1024); } while (0)
#define PG8_LDB(dst, b, h) do { _Pragma("unroll") for (int n = 0; n < 2; ++n) _Pragma("unroll") for (int k = 0; k < 2; ++k) dst[n][k] = *(const PG8_LAS bf16x8*)(lds + PG8_SB(b, h) + boff + n * 2048 + k * 1024); } while (0)
#define PG8_MMA(ai, bj, At, Bt) do { __builtin_amdgcn_s_setprio(1); _Pragma("unroll") for (int m = 0; m < 4; ++m) _Pragma("unroll") for (int n = 0; n < 2; ++n) _Pragma("unroll") for (int k = 0; k < 2; ++k) \
        acc[ai][bj][m][n] = __builtin_amdgcn_mfma_f32_16x16x32_bf16(Bt[n][k], At[m][k], acc[ai][bj][m][n], 0, 0, 0); __builtin_amdgcn_s_setprio(0); } while (0)
#define PG8_WAIT_V(n) asm volatile("s_waitcnt vmcnt(" #n ")" ::: "memory")
#define PG8_WAIT_L(n) asm volatile("s_waitcnt lgkmcnt(" #n ")" ::: "memory")
#define PG8_BAR __builtin_amdgcn_s_barrier()
#define PG8_SCHED __builtin_amdgcn_sched_barrier(0)
    Unit cur, nxt; int ui = 0;
    if (!S.next(0, cur)) return;
    f32x4 acc[2][2][4][2];
#pragma unroll
    for (int a = 0; a < 2; ++a)
#pragma unroll
        for (int b = 0; b < 2; ++b)
#pragma unroll
            for (int m = 0; m < 4; ++m)
#pragma unroll
                for (int n = 0; n < 2; ++n) acc[a][b][m][n] = (f32x4){0.f, 0.f, 0.f, 0.f};
    bf16x8 At[4][2], B0[2][2], B1[2][2];
    const char* cA = (const char*)g.A + (size_t)cur.pm * tstep; const char* cB = (const char*)g.Bt + (size_t)cur.pn * tstep;
    S.a_ready(cur);
    if constexpr (SP2) {
        PG8_STAGE(PG8_SB(0, 0), cB, voffB); PG8_STAGE(PG8_SB(0, 1), cB + hstep, voffB); PG8_STAGE(PG8_SA(0, 0), cA, voffA); PG8_STAGE(PG8_SA(0, 1), cA + hstep, voffA);
        if (wr == 1) PG8_BAR;
        PG8_WAIT_V(2); PG8_BAR;
        PG8_STAGE(PG8_SB(1, 0), cB + kstep, voffB); PG8_STAGE(PG8_SA(1, 0), cA + kstep, voffA); PG8_STAGE(PG8_SB(1, 1), cB + hstep + kstep, voffB);
        PG8_WAIT_V(6); PG8_BAR;
    } else {
        PG8_STAGE(PG8_SB(0, 0), cB, voffB); PG8_STAGE(PG8_SA(0, 0), cA, voffA); PG8_STAGE(PG8_SB(0, 1), cB + hstep, voffB); PG8_STAGE(PG8_SA(0, 1), cA + hstep, voffA);
        if (wr == 1) PG8_BAR;
        PG8_WAIT_V(4); PG8_BAR;
        PG8_STAGE(PG8_SB(1, 0), cB + kstep, voffB); PG8_STAGE(PG8_SA(1, 0), cA + kstep, voffA); PG8_STAGE(PG8_SB(1, 1), cB + hstep + kstep, voffB);
        PG8_WAIT_V(6); PG8_BAR;
    }
    for (;;) {
        const bool has_next = S.next(ui + 1, nxt);
        const char* nA = has_next ? (const char*)g.A + (size_t)nxt.pm * tstep : cA; const char* nB = has_next ? (const char*)g.Bt + (size_t)nxt.pn * tstep : cB;
        for (int t = 0; t < nt; t += 2) {
            const bool last = (t == nt - 2);
            const char* a1 = cA + (size_t)(t + 1) * kstep;
            const char* a2 = last ? nA : cA + (size_t)(t + 2) * kstep; const char* b2 = last ? nB : cB + (size_t)(t + 2) * kstep;
            const char* a3 = a2 + kstep; const char* b3 = b2 + kstep;
            if (last && has_next) S.a_ready(nxt);
            if constexpr (SP2) {
            PG8_LDB(B0, 0, 0); PG8_LDB(B1, 0, 1); PG8_SCHED; PG8_LDA(At, 0, 0); PG8_STAGE(PG8_SA(1, 1), a1 + hstep, voffA);
            PG8_WAIT_V(8); PG8_WAIT_L(0); PG8_BAR; PG8_MMA(0, 0, At, B0); PG8_MMA(0, 1, At, B1); PG8_BAR; PG8_SCHED;
            PG8_LDA(At, 0, 1); PG8_STAGE(PG8_SB(0, 0), b2, voffB); PG8_STAGE(PG8_SB(0, 1), b2 + hstep, voffB); PG8_STAGE(PG8_SA(0, 0), a2, voffA);
            PG8_WAIT_V(8); PG8_WAIT_L(0); PG8_BAR; PG8_MMA(1, 0, At, B0); PG8_MMA(1, 1, At, B1); PG8_BAR; PG8_SCHED;
            PG8_LDB(B0, 1, 0); PG8_LDB(B1, 1, 1); PG8_SCHED; PG8_LDA(At, 1, 0); PG8_STAGE(PG8_SA(0, 1), a2 + hstep, voffA);
            PG8_WAIT_V(8); PG8_WAIT_L(0); PG8_BAR; PG8_MMA(0, 0, At, B0); PG8_MMA(0, 1, At, B1); PG8_BAR; PG8_SCHED;
            PG8_LDA(At, 1, 1); PG8_STAGE(PG8_SB(1, 0), b3, voffB); PG8_STAGE(PG8_SB(1, 1), b3 + hstep, voffB); PG8_STAGE(PG8_SA(1, 0), a3, voffA);
            PG8_WAIT_V(8); PG8_WAIT_L(0); PG8_BAR; PG8_MMA(1, 0, At, B0); PG8_MMA(1, 1, At, B1); PG8_BAR; PG8_SCHED;
            } else {
            PG8_LDB(B0, 0, 0); PG8_SCHED; PG8_LDA(At, 0, 0); PG8_STAGE(PG8_SA(1, 1), a1 + hstep, voffA);
            PG8_WAIT_L(8); PG8_BAR; PG8_WAIT_L(0); PG8_MMA(0, 0, At, B0); PG8_BAR; PG8_SCHED;
            PG8_LDB(B1, 0, 1); PG8_STAGE(PG8_SB(0, 0), b2, voffB);
            PG8_BAR; PG8_WAIT_L(0); PG8_MMA(0, 1, At, B1); PG8_BAR;
            PG8_LDA(At, 0, 1); PG8_STAGE(PG8_SA(0, 0), a2, voffA);
            PG8_BAR; PG8_WAIT_L(0); PG8_MMA(1, 0, At, B0); PG8_BAR; PG8_SCHED;
            PG8_STAGE(PG8_SB(0, 1), b2 + hstep, voffB);
            PG8_WAIT_V(6); PG8_BAR; PG8_MMA(1, 1, At, B1); PG8_BAR;
            PG8_LDB(B0, 1, 0); PG8_SCHED; PG8_LDA(At, 1, 0); PG8_STAGE(PG8_SA(0, 1), a2 + hstep, voffA);
            PG8_WAIT_L(8); PG8_BAR; PG8_WAIT_L(0); PG8_MMA(0, 0, At, B0); PG8_BAR; PG8_SCHED;
            PG8_LDB(B1, 1, 1); PG8_STAGE(PG8_SB(1, 0), b3, voffB);
            PG8_BAR; PG8_WAIT_L(0); PG8_MMA(0, 1, At, B1); PG8_BAR;
            PG8_LDA(At, 1, 1); PG8_STAGE(PG8_SA(1, 0), a3, voffA);
            PG8_BAR; PG8_WAIT_L(0); PG8_MMA(1, 0, At, B0); PG8_BAR; PG8_SCHED;
            PG8_STAGE(PG8_SB(1, 1), b3 + hstep, voffB);
            PG8_WAIT_V(6); PG8_BAR; PG8_MMA(1, 1, At, B1); PG8_BAR;
            }
        }
        if constexpr (ALIGN_EPI) { if (wr == 0) PG8_BAR; }
        if constexpr (!Epi::AFTER_DRAIN) { E(acc, cur, wr, wc, fr, fq); S.done(cur); }
        if (!has_next) break;
#pragma unroll
        for (int a = 0; a < 2; ++a)
#pragma unroll
            for (int b = 0; b < 2; ++b)
#pragma unroll
                for (int m = 0; m < 4; ++m)
#pragma unroll
                    for (int n = 0; n < 2; ++n) acc[a][b][m][n] = (f32x4){0.f, 0.f, 0.f, 0.f};
        cur = nxt; cA = nA; cB = nB; ++ui;
        if constexpr (ALIGN_EPI) { if (wr == 1) PG8_BAR; }
    }
    PG8_WAIT_V(0);
    if constexpr (!ALIGN_EPI) { if (wr == 0) PG8_BAR; }
    PG8_BAR;
    if constexpr (Epi::AFTER_DRAIN) { E.fused(acc, cur, wr, wc, fr, fq, lds, wid, lane); S.done(cur); }
#undef PG8_SA
#undef PG8_SB
#undef PG8_STAGE
#undef PG8_LDA
#undef PG8_LDB
#undef PG8_MMA
#undef PG8_WAIT_V
#undef PG8_WAIT_L
#undef PG8_BAR
#undef PG8_SCHED
}
}
#define LAS __attribute__((address_space(3)))
#define DI __device__ __forceinline__
typedef unsigned short bf16;
typedef short bf16x8 __attribute__((ext_vector_type(8)));
typedef float f32x4 __attribute__((ext_vector_type(4)));
typedef float f32x2 __attribute__((ext_vector_type(2)));
typedef unsigned u32x4 __attribute__((ext_vector_type(4)));
typedef unsigned u32x2 __attribute__((ext_vector_type(2)));
typedef __bf16 bf2_t __attribute__((ext_vector_type(2)));
#define MFMA16(a, b, c) __builtin_amdgcn_mfma_f32_16x16x32_bf16((a), (b), (c), 0, 0, 0)
DI unsigned pk2(float lo, float hi) { f32x2 v = {lo, hi}; return __builtin_bit_cast(unsigned, __builtin_convertvector(v, bf2_t)); }
DI u32x2 pk4(f32x4 v) { u32x2 r; r.x = pk2(v[0], v[1]); r.y = pk2(v[2], v[3]); return r; }
DI float bf2f(bf16 h) { return __uint_as_float((unsigned)h << 16); }
DI float bflo(unsigned u) { return __uint_as_float(u << 16); }
DI float bfhi(unsigned u) { return __uint_as_float(u & 0xffff0000u); }
DI float wave_sum(float v) {
#pragma unroll
    for (int o = 1; o < 64; o <<= 1) v += __shfl_xor(v, o);
    return v;
}
DI float siluf(float y) { return y / (1.f + __expf(-y)); }

constexpr int D = 1024, SEQ = 8192, MP = 16384, MS = 128, MR = MP + MS, MPAD = 16640, NIN = 2816, INW = 2824, FF = 4096;
constexpr float EPS = 1e-6f;
constexpr size_t MiB = 1u << 20;
constexpr size_t WS_LD = 0, WS_AB = 65536;
constexpr size_t WS_WIN = 1 * MiB, WS_WOUT = 7 * MiB, WS_WUP = 9 * MiB, WS_WDN = 17 * MiB;
constexpr size_t WS_XN = 25 * MiB, WS_QT = 25 * MiB, WS_OB = 41 * MiB, WS_MIX = 58 * MiB;
constexpr size_t WS_QA = 91 * MiB, WS_KV = 107 * MiB + 512 * 1024, WS_QG = 116 * MiB, WS_SG = 116 * MiB, WS_Z = 165 * MiB, WS_MP = 182 * MiB, WS_BST = 214 * MiB;
constexpr size_t WS_T1 = 91 * MiB, WS_H = 91 * MiB, WS_T2 = 25 * MiB, WS_END = 256 * MiB;
constexpr size_t O_Y = 0, O_PSC = 16908288, O_PCK = 16917504, O_PCV = 16950272, O_PSG = 16983040, O_SSC = 17114112, O_SCK = 17703936, O_SCV = 19801088, O_SSG = 21898240;
constexpr int LDS_CTL = 147456, LDS_XB = 147456 + 64, LDS_BYTES = 147456 + 64 + 8192;
constexpr size_t WS_BAR = 32768;

struct Params { const float* in[19]; float* out; unsigned char* ws; int use_cg, pad; };

DI void p0_transpose_item(const float* W, int ldw, int N, int K, bf16* WT, LAS float* scr, int item, int lane) {
    const int nblk = N / 32, kb = item / nblk, nb = item % nblk, k0 = 64 * kb, n0 = 32 * nb;
#pragma unroll 8
    for (int i = 0; i < 32; ++i) { const int kk = 2 * i + (lane >> 5); scr[kk * 33 + (lane & 31)] = W[(size_t)(k0 + kk) * ldw + n0 + (lane & 31)]; }
    asm volatile("s_waitcnt lgkmcnt(0)" ::: "memory");
    const int c = lane & 7;
#pragma unroll
    for (int j = 0; j < 4; ++j) { const int n = (lane >> 3) + 8 * j; const LAS float* s = scr + (8 * c) * 33 + n;
        u32x4 o; o.x = pk2(s[0 * 33], s[1 * 33]); o.y = pk2(s[2 * 33], s[3 * 33]); o.z = pk2(s[4 * 33], s[5 * 33]); o.w = pk2(s[6 * 33], s[7 * 33]);
        *(u32x4*)(WT + (size_t)(n0 + n) * K + k0 + 8 * c) = o; }
    asm volatile("s_waitcnt lgkmcnt(0)" ::: "memory");
}
DI void p0_prologue(const Params& p, LAS unsigned char* lds, int gw, int NGW, int wid, int lane) {
    asm volatile("" : "+v"(lane));
    LAS float* scr = (LAS float*)(lds + wid * 16384);
    unsigned char* ws = p.ws;
    constexpr int I_IN = (D / 64) * (NIN / 32);
    for (int it = gw; it < I_IN; it += NGW) p0_transpose_item(p.in[7], INW, NIN, D, (bf16*)(ws + WS_WIN), scr, it, lane);
    f32x4 wab[4][4][2];
    const float* win = p.in[7];
#pragma unroll
    for (int j = 0; j < 4; ++j)
#pragma unroll
        for (int e = 0; e < 4; ++e) { const float* wp = win + (size_t)(4 * lane + 256 * j + e) * INW + NIN; wab[j][e][0] = *(const f32x4*)wp; wab[j][e][1] = *(const f32x4*)(wp + 4); }
    f32x4 gv[4];
#pragma unroll
    for (int j = 0; j < 4; ++j) gv[j] = *(const f32x4*)(p.in[6] + 4 * lane + 256 * j);
    bf16* XN = (bf16*)(ws + WS_XN); float* AB = (float*)(ws + WS_AB);
    f32x4 nx[4];
    { const int m0 = gw < MR ? gw : 0; const float* xr0 = m0 < MP ? p.in[0] + (size_t)m0 * D : p.in[1] + (size_t)(m0 - MP) * D;
#pragma unroll
      for (int j = 0; j < 4; ++j) nx[j] = *(const f32x4*)(xr0 + 4 * lane + 256 * j); }
    for (int m = gw; m < MR; m += NGW) {
        f32x4 v[4]; float s = 0.f;
#pragma unroll
        for (int j = 0; j < 4; ++j) { v[j] = nx[j]; s += (v[j][0] * v[j][0] + v[j][1] * v[j][1]) + (v[j][2] * v[j][2] + v[j][3] * v[j][3]); }
        { const int mn = (m + NGW < MR) ? m + NGW : m; const float* xrn = mn < MP ? p.in[0] + (size_t)mn * D : p.in[1] + (size_t)(mn - MP) * D;
#pragma unroll
          for (int j = 0; j < 4; ++j) nx[j] = *(const f32x4*)(xrn + 4 * lane + 256 * j); }
        const float rstd = 1.f / sqrtf(wave_sum(s) * (1.f / D) + EPS);
        f32x4 a0 = {0.f, 0.f, 0.f, 0.f}, a1 = {0.f, 0.f, 0.f, 0.f};
#pragma unroll
        for (int j = 0; j < 4; ++j) { v[j] = v[j] * rstd * gv[j];
#pragma unroll
            for (int e = 0; e < 4; ++e) { a0 += wab[j][e][0] * v[j][e]; a1 += wab[j][e][1] * v[j][e]; }
            *(u32x2*)(XN + (size_t)m * D + 4 * lane + 256 * j) = pk4(v[j]); }
#pragma unroll
        for (int e = 0; e < 4; ++e) { a0[e] = wave_sum(a0[e]); a1[e] = wave_sum(a1[e]); }
        if (lane == 0) { *(f32x4*)(AB + (size_t)m * 8) = a0; *(f32x4*)(AB + (size_t)m * 8 + 4) = a1; }
    }
}

DI void late_transposes(const Params& p, LAS unsigned char* lds, int gw, int NGW, int wid, int lane) {
    asm volatile("" : "+v"(lane));
    LAS float* scr = (LAS float*)(lds + wid * 16384);
    unsigned char* ws = p.ws;
    constexpr int I_O = (D / 64) * (D / 32), I_U = (D / 64) * (FF / 32), I_D = (FF / 64) * (D / 32);
    for (int it = gw; it < I_O + I_U + I_D; it += NGW) {
        int r = it;
        if (r < I_O) { p0_transpose_item(p.in[13], D, D, D, (bf16*)(ws + WS_WOUT), scr, r, lane); continue; } r -= I_O;
        if (r < I_U) { p0_transpose_item(p.in[16], FF, FF, D, (bf16*)(ws + WS_WUP), scr, r, lane); continue; } r -= I_U;
        p0_transpose_item(p.in[17], D, D, FF, (bf16*)(ws + WS_WDN), scr, r, lane);
    }
}

DI bf16x8 ldfrag(const LAS bf16* base, int pitch, int r0, int k0, int fr, int fq) { return *(const LAS bf16x8*)(base + (r0 + fr) * pitch + k0 + 8 * fq); }

DI void gdn_prep_unit(const Params& p, LAS unsigned char* lds, int unit, int tid, int wid, int lane) {
    asm volatile("" : "+v"(tid), "+v"(lane));
    const int c = unit >> 7, n = unit & 127, b = c >> 2, h = c & 3;
    const int rowbase = b * SEQ + n * 64;
    const int fr = lane & 15, fq = lane >> 4;
    unsigned char* ws = p.ws;
    LAS bf16* q_rm = (LAS bf16*)(lds);
    LAS bf16* k_rm = (LAS bf16*)(lds + 17408);
    LAS float* Amat = (LAS float*)(lds + 34816);
    LAS bf16* UT = (LAS bf16*)(lds + 17408);
    LAS bf16* XT = (LAS bf16*)(lds + 54272);
    LAS bf16* kdT = (LAS bf16*)(lds + 91136);
    LAS bf16* Tinv = (LAS bf16*)(lds + 109568);
    LAS bf16* qk = (LAS bf16*)(lds + 118784);
    LAS float* sG = (LAS float*)(lds + 128000);
    LAS float* sBeta = sG + 64; LAS float* sEG = sG + 128; LAS float* sEKD = sG + 192; LAS float* sRS = sG + 256;
    LAS float* part = Amat;
    LAS bf16* T11T = (LAS bf16*)(lds + 130048); LAS bf16* A21b = (LAS bf16*)(lds + 132608); LAS bf16* PT = (LAS bf16*)(lds + 135168);
    const bf16* QG = (const bf16*)(ws + WS_QG);
    const float* AB = (const float*)(ws + WS_AB);
    if (wid == 7) {
        const float a = AB[(size_t)(rowbase + lane) * 8 + h], bb = AB[(size_t)(rowbase + lane) * 8 + 4 + h];
        const float xs = a + p.in[11][h];
        const float sp = fmaxf(xs, 0.f) + log1pf(__expf(-fabsf(xs)));
        const float g = -__expf(p.in[10][h]) * sp;
        float G = g;
#pragma unroll
        for (int o = 1; o < 64; o <<= 1) { const float t = __int_as_float(__builtin_amdgcn_ds_bpermute(((lane - o) & 63) << 2, __float_as_int(G))); if (lane >= o) G += t; }
        const float Gl = __int_as_float(__builtin_amdgcn_readlane(__float_as_int(G), 63));
        sG[lane] = G; sBeta[lane] = 1.f / (1.f + __expf(-bb)); sEG[lane] = __expf(G); sEKD[lane] = __expf(Gl - G);
        if (lane == 63) ((float*)(ws + WS_LD))[unit] = __expf(G);
    }
    float val[8][8];
    const int cgp = tid >> 3, tr = tid & 7, prt = cgp >> 4, d0 = (cgp & 15) * 8, t0 = tr * 8;
    if (tid < 384) {
        const int col = prt * 512 + h * 128 + d0;
        float w[4][8];
#pragma unroll
        for (int i = 0; i < 4; ++i) { const f32x4 w0 = *(const f32x4*)(p.in[9] + i * 1536 + col), w1 = *(const f32x4*)(p.in[9] + i * 1536 + col + 4);
#pragma unroll
            for (int e = 0; e < 4; ++e) { w[i][e] = w0[e]; w[i][4 + e] = w1[e]; } }
#pragma unroll
        for (int tt = 0; tt < 8; ++tt)
#pragma unroll
            for (int e = 0; e < 8; ++e) val[tt][e] = 0.f;
#pragma unroll
        for (int r = 0; r < 11; ++r) {
            const int tl = n * 64 + t0 + r - 3;
            u32x4 xv = {0u, 0u, 0u, 0u};
            if (tl >= 0) xv = *(const u32x4*)(QG + (size_t)(b * SEQ + tl) * 1536 + col);
            float x[8] = {bflo(xv.x), bfhi(xv.x), bflo(xv.y), bfhi(xv.y), bflo(xv.z), bfhi(xv.z), bflo(xv.w), bfhi(xv.w)};
#pragma unroll
            for (int i = 0; i < 4; ++i) { const int tt = r - i;
                if (tt >= 0 && tt < 8) {
#pragma unroll
                    for (int e = 0; e < 8; ++e) val[tt][e] += w[i][e] * x[e]; } }
        }
#pragma unroll
        for (int tt = 0; tt < 8; ++tt) { float s = 0.f;
#pragma unroll
            for (int e = 0; e < 8; ++e) { val[tt][e] = siluf(val[tt][e]); s += val[tt][e] * val[tt][e]; }
            if (prt < 2) part[(prt * 64 + t0 + tt) * 16 + (cgp & 15)] = s; }
    }
    __syncthreads();
    if (tid < 128) { float s = 0.f;
#pragma unroll
        for (int i = 0; i < 16; ++i) s += part[tid * 16 + ((i + tid) & 15)];
        sRS[tid] = (tid < 64 ? 0.08838834764831845f : 1.f) / sqrtf(s + EPS); }
    __syncthreads();
    if (tid < 384) {
        if (prt == 0) {
#pragma unroll
            for (int tt = 0; tt < 8; ++tt) { const float r = sRS[t0 + tt]; u32x4 o; o.x = pk2(val[tt][0] * r, val[tt][1] * r); o.y = pk2(val[tt][2] * r, val[tt][3] * r); o.z = pk2(val[tt][4] * r, val[tt][5] * r); o.w = pk2(val[tt][6] * r, val[tt][7] * r);
                *(LAS u32x4*)(q_rm + (t0 + tt) * 136 + d0) = o; }
        } else if (prt == 1) {
            float be[8], kd[8];
#pragma unroll
            for (int tt = 0; tt < 8; ++tt) { const float r = sRS[64 + t0 + tt]; be[tt] = sBeta[t0 + tt] * sEG[t0 + tt]; kd[tt] = sEKD[t0 + tt];
#pragma unroll
                for (int e = 0; e < 8; ++e) val[tt][e] *= r;
                u32x4 o; o.x = pk2(val[tt][0], val[tt][1]); o.y = pk2(val[tt][2], val[tt][3]); o.z = pk2(val[tt][4], val[tt][5]); o.w = pk2(val[tt][6], val[tt][7]);
                *(LAS u32x4*)(k_rm + (t0 + tt) * 136 + d0) = o; }
#pragma unroll
            for (int e = 0; e < 8; ++e) { u32x4 o, o2;
                o.x = pk2(val[0][e] * be[0], val[1][e] * be[1]); o.y = pk2(val[2][e] * be[2], val[3][e] * be[3]); o.z = pk2(val[4][e] * be[4], val[5][e] * be[5]); o.w = pk2(val[6][e] * be[6], val[7][e] * be[7]);
                o2.x = pk2(val[0][e] * kd[0], val[1][e] * kd[1]); o2.y = pk2(val[2][e] * kd[2], val[3][e] * kd[3]); o2.z = pk2(val[4][e] * kd[4], val[5][e] * kd[5]); o2.w = pk2(val[6][e] * kd[6], val[7][e] * kd[7]);
                *(LAS u32x4*)(XT + (128 + d0 + e) * 72 + t0) = o; *(LAS u32x4*)(kdT + (d0 + e) * 72 + t0) = o2; }
        } else {
            float be[8];
#pragma unroll
            for (int tt = 0; tt < 8; ++tt) be[tt] = sBeta[t0 + tt];
#pragma unroll
            for (int e = 0; e < 8; ++e) { u32x4 o;
                o.x = pk2(val[0][e] * be[0], val[1][e] * be[1]); o.y = pk2(val[2][e] * be[2], val[3][e] * be[3]); o.z = pk2(val[4][e] * be[4], val[5][e] * be[5]); o.w = pk2(val[6][e] * be[6], val[7][e] * be[7]);
                *(LAS u32x4*)(XT + (d0 + e) * 72 + t0) = o; }
        }
    }
    __syncthreads();
#pragma unroll
    for (int q = 0; q < 2; ++q) { const int idx = wid + 8 * q, it = idx >> 2, jt = idx & 3;
        if (jt <= it) { f32x4 acc = {0.f, 0.f, 0.f, 0.f};
#pragma unroll
            for (int s = 0; s < 4; ++s) acc = MFMA16(ldfrag(k_rm, 136, it * 16, 32 * s, fr, fq), ldfrag(k_rm, 136, jt * 16, 32 * s, fr, fq), acc);
            const int j = jt * 16 + fr; const float Gj = sG[j];
#pragma unroll
            for (int i2 = 0; i2 < 4; ++i2) { const int i = it * 16 + 4 * fq + i2; const float av = sBeta[i] * acc[i2] * __expf(fminf(sG[i] - Gj, 0.f)); Amat[i * 68 + j] = av;
                if (it >= 2 && jt < 2) A21b[(i - 32) * 40 + j] = (bf16)(pk2(av, 0.f) & 0xffffu); } } }
    __syncthreads();
    if (wid < 2) {
#ifndef NOINV
        const int o = 32 * wid, cl = lane & 31;
        float T[32];
#pragma unroll
        for (int i = 0; i < 32; ++i) { float a = (i == cl) ? 1.f : 0.f;
#pragma unroll
            for (int jg = 0; jg < (i + 3) / 4; ++jg) { const f32x4 av = *(const LAS f32x4*)(Amat + (o + i) * 68 + o + 4 * jg);
#pragma unroll
                for (int e = 0; e < 4; ++e) if (4 * jg + e < i) a -= av[e] * T[4 * jg + e]; }
            T[i] = a; }
        if (lane < 32) {
#pragma unroll
            for (int i = 0; i < 32; i += 2) { const unsigned pk = pk2(T[i], T[i + 1]); Tinv[(o + i) * 72 + o + cl] = (bf16)(pk & 0xffffu); Tinv[(o + i + 1) * 72 + o + cl] = (bf16)(pk >> 16); }
            if (wid == 0) {
#pragma unroll
                for (int i = 0; i < 32; i += 8) { u32x4 w; w.x = pk2(T[i], T[i + 1]); w.y = pk2(T[i + 2], T[i + 3]); w.z = pk2(T[i + 4], T[i + 5]); w.w = pk2(T[i + 6], T[i + 7]); *(LAS u32x4*)(T11T + cl * 40 + i) = w; } }
        } else if (wid == 0) {
#pragma unroll
            for (int i = 0; i < 32; ++i) Tinv[i * 72 + 32 + cl] = 0;
        }
#endif
    } else {
        for (int idx = wid - 2; idx < 16; idx += 6) { const int it = idx >> 2, jt = idx & 3;
            f32x4 acc = {0.f, 0.f, 0.f, 0.f};
            if (jt <= it) {
#pragma unroll
                for (int s = 0; s < 4; ++s) acc = MFMA16(ldfrag(k_rm, 136, jt * 16, 32 * s, fr, fq), ldfrag(q_rm, 136, it * 16, 32 * s, fr, fq), acc);
                const int i = it * 16 + fr; const float Gi = sG[i];
#pragma unroll
                for (int i2 = 0; i2 < 4; ++i2) { const int j = jt * 16 + 4 * fq + i2; acc[i2] = (i >= j) ? acc[i2] * __expf(fminf(Gi - sG[j], 0.f)) : 0.f; } }
            *(LAS u32x2*)(qk + (it * 16 + fr) * 72 + jt * 16 + 4 * fq) = pk4(acc); }
    }
    __syncthreads();
    if (wid == 0) {
#pragma unroll
        for (int jt = 0; jt < 2; ++jt) { const bf16x8 yv = *(const LAS bf16x8*)(T11T + (jt * 16 + fr) * 40 + 8 * fq);
#pragma unroll
            for (int it = 0; it < 2; ++it) { f32x4 a = {0.f, 0.f, 0.f, 0.f}; a = MFMA16(*(const LAS bf16x8*)(A21b + (it * 16 + fr) * 40 + 8 * fq), yv, a);
                *(LAS u32x2*)(PT + (jt * 16 + fr) * 40 + it * 16 + 4 * fq) = pk4(a); } }
        asm volatile("s_waitcnt lgkmcnt(0)" ::: "memory");
#pragma unroll
        for (int jt = 0; jt < 2; ++jt) { const bf16x8 yv = *(const LAS bf16x8*)(PT + (jt * 16 + fr) * 40 + 8 * fq);
#pragma unroll
            for (int it = 0; it < 2; ++it) { f32x4 a = {0.f, 0.f, 0.f, 0.f}; a = MFMA16(*(const LAS bf16x8*)(Tinv + (32 + it * 16 + fr) * 72 + 32 + 8 * fq), yv, a);
                const u32x2 w = pk4(-a); const int j = jt * 16 + fr, i0 = 32 + it * 16 + 4 * fq;
                Tinv[i0 * 72 + j] = (bf16)(w.x & 0xffffu); Tinv[(i0 + 1) * 72 + j] = (bf16)(w.x >> 16); Tinv[(i0 + 2) * 72 + j] = (bf16)(w.y & 0xffffu); Tinv[(i0 + 3) * 72 + j] = (bf16)(w.y >> 16); } }
    }
    __syncthreads();
    { int t2 = threadIdx.x; asm volatile("" : "+v"(t2)); lane = t2 & 63; }
    const int fr3 = lane & 15, fq3 = lane >> 4;
#pragma unroll
    for (int q = 0; q < 2; ++q) { const int ft = 2 * wid + q;
        const bf16x8 y0 = ldfrag(XT, 72, ft * 16, 0, fr3, fq3), y1 = ldfrag(XT, 72, ft * 16, 32, fr3, fq3);
        f32x4 acc[4];
#pragma unroll
        for (int ct = 0; ct < 4; ++ct) { acc[ct] = (f32x4){0.f, 0.f, 0.f, 0.f}; acc[ct] = MFMA16(ldfrag(Tinv, 72, ct * 16, 0, fr3, fq3), y0, acc[ct]); acc[ct] = MFMA16(ldfrag(Tinv, 72, ct * 16, 32, fr3, fq3), y1, acc[ct]); }
#pragma unroll
        for (int ct = 0; ct < 4; ++ct) *(LAS u32x2*)(UT + (ft * 16 + fr3) * 72 + ct * 16 + 4 * fq3) = pk4(acc[ct]); }
    __syncthreads();
    {
        bf16* MPo = (bf16*)(ws + WS_MP) + (size_t)unit * 16384;
        bf16* BSo = (bf16*)(ws + WS_BST) + (size_t)unit * 16384;
        bf16* QTo = (bf16*)(ws + WS_QT) + (size_t)unit * 8192;
        bf16* OBo = (bf16*)(ws + WS_OB) + (size_t)unit * 8192;
        const bf16x8 w0 = ldfrag(UT, 72, 128 + wid * 16, 0, fr3, fq3), w1 = ldfrag(UT, 72, 128 + wid * 16, 32, fr3, fq3);
        const bf16x8 kd0 = ldfrag(kdT, 72, wid * 16, 0, fr3, fq3), kd1 = ldfrag(kdT, 72, wid * 16, 32, fr3, fq3);
        const bf16x8 u0 = ldfrag(UT, 72, wid * 16, 0, fr3, fq3), u1 = ldfrag(UT, 72, wid * 16, 32, fr3, fq3);
#pragma unroll
        for (int dt = 0; dt < 8; ++dt) {
            f32x4 a = {0.f, 0.f, 0.f, 0.f};
            a = MFMA16(w0, ldfrag(kdT, 72, dt * 16, 0, fr3, fq3), a); a = MFMA16(w1, ldfrag(kdT, 72, dt * 16, 32, fr3, fq3), a);
            const int s = wid >> 1, jb = (wid & 1) * 4, blk = dt * 4 + s;
            *(u32x2*)(MPo + ((size_t)(blk * 64 + lane) * 8 + jb)) = pk4(-a);
            f32x4 bacc = {0.f, 0.f, 0.f, 0.f};
            bacc = MFMA16(kd0, ldfrag(UT, 72, dt * 16, 0, fr3, fq3), bacc); bacc = MFMA16(kd1, ldfrag(UT, 72, dt * 16, 32, fr3, fq3), bacc);
            *(u32x2*)(BSo + ((size_t)((dt * 8 + wid) * 64 + lane) * 4)) = pk4(bacc);
        }
#pragma unroll
        for (int ct = 0; ct < 4; ++ct) {
            const bf16x8 y0 = ldfrag(qk, 72, ct * 16, 0, fr3, fq3), y1 = ldfrag(qk, 72, ct * 16, 32, fr3, fq3);
            f32x4 a = {0.f, 0.f, 0.f, 0.f}; a = MFMA16(w0, y0, a); a = MFMA16(w1, y1, a);
            const int cc = ct * 16 + fr3, dd = wid * 16 + 4 * fq3; const float eg = sEG[cc];
            const u32x2 qv = *(const LAS u32x2*)(q_rm + cc * 136 + dd);
            f32x4 o; o[0] = bflo(qv.x) * eg - a[0]; o[1] = bfhi(qv.x) * eg - a[1]; o[2] = bflo(qv.y) * eg - a[2]; o[3] = bfhi(qv.y) * eg - a[3];
            *(u32x2*)(QTo + cc * 128 + dd) = pk4(o);
            f32x4 ob = {0.f, 0.f, 0.f, 0.f}; ob = MFMA16(u0, y0, ob); ob = MFMA16(u1, y1, ob);
            *(u32x2*)(OBo + cc * 128 + dd) = pk4(ob);
        }
    }
    __syncthreads();
}
DI void scan_issue(const char* MPc, const char* BSc, LAS unsigned char* lds, int n, int lw, int lane) {
    const int slot = n & 3;
#pragma unroll
    for (int q = 0; q < 9; ++q) { const int blk = lw * 9 + q;
        const char* src = blk < 32 ? MPc + (size_t)n * 32768 + blk * 1024 : BSc + (size_t)n * 32768 + (blk - 32) * 1024;
        __builtin_amdgcn_global_load_lds((const unsigned*)(src + lane * 16), (LAS unsigned*)(lds + slot * 36864 + blk * 1024), 16, 0, 0); }
}
constexpr int PFD = 64;
template <int PART> DI void scan_phase(const Params& p, LAS unsigned char* lds, int wg, int wid, int lane) {
    constexpr int N0 = PART * 64, N1 = N0 + 64;
    asm volatile("" : "+v"(lane));
    const int c = wg & 7, sl = wg >> 3, fr = lane & 15, fq = lane >> 4, e0 = sl * 16;
    unsigned char* ws = p.ws;
    const char* MPc = (const char*)(ws + WS_MP) + (size_t)c * 128 * 32768;
    const char* BSc = (const char*)(ws + WS_BST) + (size_t)c * 128 * 32768 + sl * 4096;
    bf16* SGc = (bf16*)p.out + (size_t)c * 128 * 16384;
    const float* LD = (const float*)(ws + WS_LD) + c * 128;
    const bool loader = (wid >= 1 && wid <= 4); const int lw = wid - 1;
    unsigned pfdummy = 0u;
    f32x4 acc[8];
#pragma unroll
    for (int t = 0; t < 8; ++t) acc[t] = (f32x4){0.f, 0.f, 0.f, 0.f};
    float ldv0 = 0.f;
    if (wid == 0) { ldv0 = LD[N0 + lane];
        if (PART == 1) {
#pragma unroll
            for (int t = 0; t < 8; ++t) acc[t] = *(const LAS f32x4*)(lds + LDS_XB + (t * 64 + lane) * 16); } }
    if (loader) { scan_issue(MPc, BSc, lds, N0, lw, lane); scan_issue(MPc, BSc, lds, N0 + 1, lw, lane); scan_issue(MPc, BSc, lds, N0 + 2, lw, lane); asm volatile("s_waitcnt vmcnt(18)" ::: "memory"); }
    __builtin_amdgcn_s_barrier(); asm volatile("" ::: "memory");
    for (int n = N0; n < N1; ++n) {
        if (loader) { if (n + 3 < N1) { scan_issue(MPc, BSc, lds, n + 3, lw, lane); asm volatile("s_waitcnt vmcnt(18)" ::: "memory"); } else { asm volatile("s_waitcnt vmcnt(0)" ::: "memory"); } }
        if (wid == 5 && n + PFD < N1) {
            const char* pm = MPc + (size_t)(n + PFD) * 32768 + lane * 128; const char* pb = BSc + (size_t)(n + PFD) * 32768 + (lane & 31) * 128;
            asm volatile("global_load_dword %0, %1, off\n\tglobal_load_dword %0, %2, off\n\tglobal_load_dword %0, %3, off\n\tglobal_load_dword %0, %4, off\n\tglobal_load_dword %0, %5, off" : "+v"(pfdummy) : "v"(pm), "v"(pm + 8192), "v"(pm + 16384), "v"(pm + 24576), "v"(pb) : "memory");
        }
        if (wid == 0) {
            const LAS unsigned char* slot = lds + (n & 3) * 36864;
            bf16x8 mf[8][4];
#pragma unroll
            for (int m = 0; m < 4; ++m)
#pragma unroll
                for (int s = 0; s < 4; ++s) mf[m][s] = *(const LAS bf16x8*)(slot + (m * 4 + s) * 1024 + lane * 16);
            __builtin_amdgcn_sched_barrier(0);
            const float ld = __int_as_float(__builtin_amdgcn_readlane(__float_as_int(ldv0), n & 63));
            u32x2 pk[8];
#pragma unroll
            for (int t = 0; t < 8; ++t) { pk[t] = pk4(acc[t]); *(u32x2*)(SGc + (size_t)n * 16384 + (e0 + fr) * 128 + 16 * t + 4 * fq) = pk[t]; }
            bf16x8 Sb[4];
#pragma unroll
            for (int s = 0; s < 4; ++s) { u32x4 v; v.x = pk[2 * s].x; v.y = pk[2 * s].y; v.z = pk[2 * s + 1].x; v.w = pk[2 * s + 1].y; Sb[s] = __builtin_bit_cast(bf16x8, v); }
#pragma unroll
            for (int t = 0; t < 8; ++t) { const u32x2 bb = *(const LAS u32x2*)(slot + 32768 + t * 512 + lane * 8);
                acc[t][0] = ld * acc[t][0] + bflo(bb.x); acc[t][1] = ld * acc[t][1] + bfhi(bb.x); acc[t][2] = ld * acc[t][2] + bflo(bb.y); acc[t][3] = ld * acc[t][3] + bfhi(bb.y); }
            __builtin_amdgcn_sched_barrier(0);
#pragma unroll
            for (int m = 4; m < 8; ++m)
#pragma unroll
                for (int s = 0; s < 4; ++s) mf[m][s] = *(const LAS bf16x8*)(slot + (m * 4 + s) * 1024 + lane * 16);
            __builtin_amdgcn_sched_barrier(0);
#pragma unroll
            for (int s = 0; s < 4; ++s)
#pragma unroll
                for (int m = 0; m < 4; ++m) acc[m] = MFMA16(mf[m][s], Sb[s], acc[m]);
            __builtin_amdgcn_sched_barrier(0);
#pragma unroll
            for (int s = 0; s < 4; ++s)
#pragma unroll
                for (int m = 4; m < 8; ++m) acc[m] = MFMA16(mf[m][s], Sb[s], acc[m]);
            asm volatile("s_waitcnt lgkmcnt(0)" ::: "memory");
        }
        __builtin_amdgcn_s_barrier(); asm volatile("" ::: "memory");
    }
    if (wid == 0 && PART == 0) {
#pragma unroll
        for (int t = 0; t < 8; ++t) *(LAS f32x4*)(lds + LDS_XB + (t * 64 + lane) * 16) = acc[t]; }
    if (wid == 0 && PART == 1) { float* So = p.out + O_PSG + (size_t)c * 16384;
#pragma unroll
        for (int t = 0; t < 8; ++t)
#pragma unroll
            for (int i = 0; i < 4; ++i) So[(16 * t + 4 * fq + i) * 128 + e0 + fr] = acc[t][i]; }
    asm volatile("s_waitcnt vmcnt(0)" : "+v"(pfdummy) :: "memory");
    __syncthreads();
}

DI void attn_unit(const Params& p, LAS unsigned char* lds, int unit, int tid, int wid, int lane) {
    asm volatile("" : "+v"(tid), "+v"(lane));
    const int kvh = unit & 1, nb = (unit >> 1) & 63, b = unit >> 7;
    const int fr = lane & 15, fq = lane >> 4;
    unsigned char* ws = p.ws;
    const bf16* QA = (const bf16*)(ws + WS_QA); const bf16* KV = (const bf16*)(ws + WS_KV); bf16* MIX = (bf16*)(ws + WS_MIX);
    LAS bf16* Ks = (LAS bf16*)lds;
    LAS bf16* Vt = (LAS bf16*)(lds + 36864);
    const int tok0 = b * SEQ + 128 * (nb - 1);
    for (int it = tid; it < 2048; it += 512) { const int key = it >> 3, ch = it & 7;
        u32x4 kv = {0u, 0u, 0u, 0u}, vv = {0u, 0u, 0u, 0u};
        if (nb > 0 || key >= 128) { const bf16* src = KV + (size_t)(tok0 + key) * 256 + kvh * 64 + ch * 8; kv = *(const u32x4*)src; vv = *(const u32x4*)(src + 128); }
        *(LAS u32x4*)(Ks + key * 72 + ch * 8) = kv;
        LAS bf16* vd = Vt + (ch * 8) * 280 + key;
        vd[0] = (bf16)(vv.x & 0xffffu); vd[280] = (bf16)(vv.x >> 16); vd[560] = (bf16)(vv.y & 0xffffu); vd[840] = (bf16)(vv.y >> 16);
        vd[1120] = (bf16)(vv.z & 0xffffu); vd[1400] = (bf16)(vv.z >> 16); vd[1680] = (bf16)(vv.w & 0xffffu); vd[1960] = (bf16)(vv.w >> 16); }
    for (int it = tid; it < 64 * 24; it += 512) Vt[(it / 24) * 280 + 256 + (it % 24)] = 0;
    __syncthreads();
    const int g = wid >> 1, h = kvh * 4 + g, qh = wid & 1;
    const float slope = exp2f(-(float)(h + 1)), sink = p.in[8][h];
    for (int qt = 0; qt < 4; ++qt) {
        const int q0 = 64 * qh + 16 * qt;
        const size_t qrow = (size_t)(b * SEQ + 128 * nb + q0 + fr);
        const bf16x8 qf0 = *(const bf16x8*)(QA + qrow * 512 + h * 64 + 8 * fq), qf1 = *(const bf16x8*)(QA + qrow * 512 + h * 64 + 32 + 8 * fq);
        f32x4 sc[10]; float mx = sink;
#pragma unroll
        for (int kt = 0; kt < 9; ++kt) { const int ks0 = q0 + 16 * kt;
            f32x4 a = {0.f, 0.f, 0.f, 0.f};
            a = MFMA16(ldfrag(Ks, 72, ks0, 0, fr, fq), qf0, a); a = MFMA16(ldfrag(Ks, 72, ks0, 32, fr, fq), qf1, a);
#pragma unroll
            for (int i = 0; i < 4; ++i) { const int si = ks0 + 4 * fq + i, dist = 128 + q0 + fr - si;
                const bool ok = (dist >= 0) && (dist <= 128) && (nb > 0 || si >= 128);
                a[i] = ok ? a[i] * 0.125f - slope * (float)dist : -INFINITY; mx = fmaxf(mx, a[i]); }
            sc[kt] = a; }
        mx = fmaxf(mx, __shfl_xor(mx, 16)); mx = fmaxf(mx, __shfl_xor(mx, 32));
        float sum = 0.f;
#pragma unroll
        for (int kt = 0; kt < 9; ++kt)
#pragma unroll
            for (int i = 0; i < 4; ++i) { const float e = __expf(sc[kt][i] - mx); sc[kt][i] = e; sum += e; }
        sc[9] = (f32x4){0.f, 0.f, 0.f, 0.f};
        sum += __shfl_xor(sum, 16); sum += __shfl_xor(sum, 32);
        const float inv = 1.f / (sum + __expf(sink - mx));
        f32x4 o[4];
#pragma unroll
        for (int dt = 0; dt < 4; ++dt) o[dt] = (f32x4){0.f, 0.f, 0.f, 0.f};
#pragma unroll
        for (int s2 = 0; s2 < 5; ++s2) { const u32x2 p0 = pk4(sc[2 * s2]), p1 = pk4(sc[2 * s2 + 1]);
            u32x4 pv; pv.x = p0.x; pv.y = p0.y; pv.z = p1.x; pv.w = p1.y; const bf16x8 pb = __builtin_bit_cast(bf16x8, pv);
#pragma unroll
            for (int dt = 0; dt < 4; ++dt) { const LAS bf16* vp = Vt + (dt * 16 + fr) * 280 + q0 + 32 * s2 + 4 * fq;
                const u32x2 va = *(const LAS u32x2*)vp, vb = *(const LAS u32x2*)(vp + 16);
                u32x4 vv; vv.x = va.x; vv.y = va.y; vv.z = vb.x; vv.w = vb.y;
                o[dt] = MFMA16(__builtin_bit_cast(bf16x8, vv), pb, o[dt]); } }
#pragma unroll
        for (int dt = 0; dt < 4; ++dt) *(u32x2*)(MIX + qrow * 1024 + h * 64 + dt * 16 + 4 * fq) = pk4(o[dt] * inv);
    }
    __syncthreads();
}

DI void gdn_out_pair(const Params& p, int pair, int wid, int lane) {
    asm volatile("" : "+v"(lane));
    const int unit = pair * 2 + (wid >> 2), ct = wid & 3;
    const int c = unit >> 7, n = unit & 127, b = c >> 2, h = c & 3, fr = lane & 15, fq = lane >> 4;
    unsigned char* ws = p.ws;
    const bf16* QTo = (const bf16*)(ws + WS_QT) + (size_t)unit * 8192;
    const bf16* OBo = (const bf16*)(ws + WS_OB) + (size_t)unit * 8192;
    const bf16* SGo = (const bf16*)p.out + (size_t)unit * 16384;
    const int tokc = ct * 16 + fr; const size_t row = (size_t)(b * SEQ + n * 64 + tokc);
    bf16x8 qf[4];
#pragma unroll
    for (int s = 0; s < 4; ++s) qf[s] = *(const bf16x8*)(QTo + tokc * 128 + 32 * s + 8 * fq);
    u32x2 obv[8], zv[8];
#pragma unroll
    for (int t = 0; t < 8; ++t) { obv[t] = *(const u32x2*)(OBo + tokc * 128 + 16 * t + 4 * fq); zv[t] = *(const u32x2*)((const bf16*)(ws + WS_Z) + row * 512 + h * 128 + 16 * t + 4 * fq); }
    bf16x8 sf[8][4];
#pragma unroll
    for (int t = 0; t < 8; ++t)
#pragma unroll
        for (int s = 0; s < 4; ++s) sf[t][s] = *(const bf16x8*)(SGo + (16 * t + fr) * 128 + 32 * s + 8 * fq);
    f32x4 gnv[8];
#pragma unroll
    for (int t = 0; t < 8; ++t) gnv[t] = *(const f32x4*)(p.in[12] + 16 * t + 4 * fq);
    f32x4 o[8]; float ss = 0.f;
#pragma unroll
    for (int t = 0; t < 8; ++t) {
        f32x4 a = {bflo(obv[t].x), bfhi(obv[t].x), bflo(obv[t].y), bfhi(obv[t].y)};
#pragma unroll
        for (int s = 0; s < 4; ++s) a = MFMA16(sf[t][s], qf[s], a);
        o[t] = a; ss += (a[0] * a[0] + a[1] * a[1]) + (a[2] * a[2] + a[3] * a[3]); }
    ss += __shfl_xor(ss, 16); ss += __shfl_xor(ss, 32);
    const float rstd = 1.f / sqrtf(ss * (1.f / 128.f) + EPS);
    bf16* MIX = (bf16*)(ws + WS_MIX);
#pragma unroll
    for (int t = 0; t < 8; ++t) { const int e = 16 * t + 4 * fq;
        const f32x4 gn = gnv[t];
        f32x4 y; y[0] = o[t][0] * rstd * gn[0] * siluf(bflo(zv[t].x)); y[1] = o[t][1] * rstd * gn[1] * siluf(bfhi(zv[t].x)); y[2] = o[t][2] * rstd * gn[2] * siluf(bflo(zv[t].y)); y[3] = o[t][3] * rstd * gn[3] * siluf(bfhi(zv[t].y));
        *(u32x2*)(MIX + row * 1024 + 512 + h * 128 + e) = pk4(y); }
}

DI void sample_gdn_unit(const Params& p, LAS unsigned char* lds, int unit, int tid, int wid, int lane) {
    asm volatile("" : "+v"(tid), "+v"(lane));
    const int b = unit >> 2, h = unit & 3; const size_t row = MP + b;
    unsigned char* ws = p.ws;
    LAS float* qs = (LAS float*)lds; LAS float* ks = qs + 128; LAS float* vs = qs + 256; LAS float* red = qs + 384; LAS float* red2 = qs + 896; LAS float* ssw = qs + 1408;
    const bf16* QG = (const bf16*)(ws + WS_QG); const float* AB = (const float*)(ws + WS_AB);
    const int e = tid & 127, dg = tid >> 7;
    const float* S0 = p.in[5] + ((size_t)(b * 4 + h) * 128 + dg * 32) * 128 + e;
    float S[32];
#pragma unroll
    for (int i = 0; i < 32; ++i) S[i] = S0[i * 128];
    const float a_ab = AB[row * 8 + h], b_ab = AB[row * 8 + 4 + h], dtb = p.in[11][h], alog = p.in[10][h];
    const float zraw = bf2f(((const bf16*)(ws + WS_Z))[row * 512 + h * 128 + e]), gnv = p.in[12][e];
    float val = 0.f; const int prt = tid >> 7, d = tid & 127;
    if (tid < 384) { const int col = prt * 512 + h * 128 + d; const float* cw = p.in[9]; const float* sc = p.in[2] + (size_t)b * 3 * 1536 + col;
        const float y = cw[col] * sc[0] + cw[1536 + col] * sc[1536] + cw[3072 + col] * sc[3072] + cw[4608 + col] * bf2f(QG[row * 1536 + col]);
        val = siluf(y); const float s = wave_sum(val * val); if (lane == 0) ssw[wid] = s; }
    __syncthreads();
    if (tid < 384) { if (prt == 0) qs[d] = val * 0.08838834764831845f / sqrtf(ssw[0] + ssw[1] + EPS); else if (prt == 1) ks[d] = val / sqrtf(ssw[2] + ssw[3] + EPS); else vs[d] = val; }
    __syncthreads();
    const float xs = a_ab + dtb;
    const float g = -__expf(alog) * (fmaxf(xs, 0.f) + log1pf(__expf(-fabsf(xs))));
    const float beta = 1.f / (1.f + __expf(-b_ab)), eg = __expf(g);
    float kvp = 0.f;
#pragma unroll
    for (int i = 0; i < 32; ++i) { S[i] *= eg; kvp += ks[dg * 32 + i] * S[i]; }
    red[dg * 128 + e] = kvp;
    __syncthreads();
    const float u = (vs[e] - (red[e] + red[128 + e] + red[256 + e] + red[384 + e])) * beta;
    float* So = p.out + O_SSG + ((size_t)(b * 4 + h) * 128 + dg * 32) * 128 + e; float op = 0.f;
#pragma unroll
    for (int i = 0; i < 32; ++i) { S[i] += ks[dg * 32 + i] * u; op += qs[dg * 32 + i] * S[i]; So[i * 128] = S[i]; }
    red2[dg * 128 + e] = op;
    __syncthreads();
    float o = 0.f;
    if (tid < 128) { o = red2[e] + red2[128 + e] + red2[256 + e] + red2[384 + e]; const float s = wave_sum(o * o); if (lane == 0) ssw[8 + wid] = s; }
    __syncthreads();
    if (tid < 128) { const float rstd = 1.f / sqrtf((ssw[8] + ssw[9]) * (1.f / 128.f) + EPS);
        const float y = o * rstd * gnv * siluf(zraw);
        ((bf16*)(ws + WS_MIX))[row * 1024 + 512 + h * 128 + e] = (bf16)(pk2(y, 0.f) & 0xffffu); }
    __syncthreads();
}
DI void sample_attn_unit(const Params& p, LAS unsigned char* lds, int b, int tid, int wid, int lane) {
    asm volatile("" : "+v"(tid), "+v"(lane));
    unsigned char* ws = p.ws; const size_t row = MP + b;
    const bf16* QA = (const bf16*)(ws + WS_QA); const bf16* KV = (const bf16*)(ws + WS_KV);
    LAS float* Kl = (LAS float*)lds;
    LAS float* Vl = (LAS float*)(lds + 2 * 128 * 68 * 4);
    const float* kc = p.in[3] + (size_t)b * 16384; const float* vc = p.in[4] + (size_t)b * 16384;
    float* ok = p.out + O_SCK + (size_t)b * 16384; float* ov = p.out + O_SCV + (size_t)b * 16384;
    f32x4 kreg[8], vreg[8];
#pragma unroll
    for (int q = 0; q < 8; ++q) { const int i4 = tid + 512 * q; kreg[q] = *(const f32x4*)(kc + 4 * i4); vreg[q] = *(const f32x4*)(vc + 4 * i4); }
#pragma unroll
    for (int q = 0; q < 8; ++q) { const int i4 = tid + 512 * q, key = i4 >> 5, kvh = (i4 >> 4) & 1, d4 = (i4 & 15) * 4;
        *(LAS f32x4*)(Kl + (kvh * 128 + key) * 68 + d4) = kreg[q]; *(LAS f32x4*)(Vl + (kvh * 128 + key) * 68 + d4) = vreg[q];
        if (key >= 1) { *(f32x4*)(ok + 4 * i4 - 128) = kreg[q]; *(f32x4*)(ov + 4 * i4 - 128) = vreg[q]; } }
    if (tid < 32) { const u32x2 kn = *(const u32x2*)(KV + row * 256 + 4 * tid), vn = *(const u32x2*)(KV + row * 256 + 128 + 4 * tid);
        *(f32x4*)(ok + 127 * 128 + 4 * tid) = (f32x4){bflo(kn.x), bfhi(kn.x), bflo(kn.y), bfhi(kn.y)}; *(f32x4*)(ov + 127 * 128 + 4 * tid) = (f32x4){bflo(vn.x), bfhi(vn.x), bflo(vn.y), bfhi(vn.y)}; }
    __syncthreads();
    const int h = wid, kvh = h >> 2;
    const float slope = exp2f(-(float)(h + 1)), sink = p.in[8][h];
    const LAS float* Kh = Kl + kvh * 128 * 68; const LAS float* Vh = Vl + kvh * 128 * 68;
    float s0 = 0.f, s1 = 0.f, s2 = 0.f;
#pragma unroll
    for (int c4 = 0; c4 < 16; ++c4) { const u32x2 qv = *(const u32x2*)(QA + row * 512 + h * 64 + 4 * c4);
        const float q0 = bflo(qv.x), q1 = bfhi(qv.x), q2 = bflo(qv.y), q3 = bfhi(qv.y);
        const f32x4 k0 = *(const LAS f32x4*)(Kh + lane * 68 + 4 * c4), k1 = *(const LAS f32x4*)(Kh + (lane + 64) * 68 + 4 * c4);
        const u32x2 kn = *(const u32x2*)(KV + row * 256 + kvh * 64 + 4 * c4);
        s0 += q0 * k0[0] + q1 * k0[1] + q2 * k0[2] + q3 * k0[3]; s1 += q0 * k1[0] + q1 * k1[1] + q2 * k1[2] + q3 * k1[3];
        s2 += q0 * bflo(kn.x) + q1 * bfhi(kn.x) + q2 * bflo(kn.y) + q3 * bfhi(kn.y); }
    s0 = s0 * 0.125f - slope * (float)(128 - lane); s1 = s1 * 0.125f - slope * (float)(64 - lane); s2 = s2 * 0.125f;
    float mx = fmaxf(fmaxf(s0, s1), fmaxf(s2, sink));
#pragma unroll
    for (int o = 1; o < 64; o <<= 1) mx = fmaxf(mx, __shfl_xor(mx, o));
    const float p0 = __expf(s0 - mx), p1 = __expf(s1 - mx), p2 = __expf(s2 - mx);
    const float inv = 1.f / (wave_sum(p0 + p1) + p2 + __expf(sink - mx));
    float o = p2 * bf2f(KV[row * 256 + 128 + kvh * 64 + lane]);
#pragma unroll
    for (int j = 0; j < 64; ++j) { o += __int_as_float(__builtin_amdgcn_readlane(__float_as_int(p0), j)) * Vh[j * 68 + lane] + __int_as_float(__builtin_amdgcn_readlane(__float_as_int(p1), j)) * Vh[(j + 64) * 68 + lane]; }
    ((bf16*)(ws + WS_MIX))[row * 1024 + h * 64 + lane] = (bf16)(pk2(o * inv, 0.f) & 0xffffu);
    __syncthreads();
}
DI void state_copies(const Params& p, int gtid, int nthr) {
    unsigned char* ws = p.ws; const bf16* QG = (const bf16*)(ws + WS_QG); const bf16* KV = (const bf16*)(ws + WS_KV);
    for (int idx = gtid; idx < 9216; idx += nthr) { const int b = idx / 4608, i = (idx % 4608) / 1536, ch = idx % 1536; p.out[O_PSC + idx] = bf2f(QG[(size_t)(b * SEQ + SEQ - 3 + i) * 1536 + ch]); }
    for (int idx = gtid; idx < 32768; idx += nthr) { const int b = idx >> 14, j = (idx >> 7) & 127, cc = idx & 127; const size_t r = (size_t)(b * SEQ + SEQ - 128 + j) * 256;
        p.out[O_PCK + idx] = bf2f(KV[r + cc]); p.out[O_PCV + idx] = bf2f(KV[r + 128 + cc]); }
    for (int idx = gtid; idx < 589824; idx += nthr) { const int b = idx / 4608, i = (idx % 4608) / 1536, ch = idx % 1536;
        p.out[O_SSC + idx] = i < 2 ? p.in[2][(size_t)(b * 3 + i + 1) * 1536 + ch] : bf2f(QG[(size_t)(MP + b) * 1536 + ch]); }
}

DI void norm_rows_mid(const Params& p, int gw, int NGW, int lane) {
    asm volatile("" : "+v"(lane));
    unsigned char* ws = p.ws; const bf16* T1 = (const bf16*)(ws + WS_T1); bf16* XN = (bf16*)(ws + WS_XN); bf16* X1B = (bf16*)(ws + WS_MIX);
    f32x4 g1[4], g2[4];
#pragma unroll
    for (int j = 0; j < 4; ++j) { g1[j] = *(const f32x4*)(p.in[14] + 4 * lane + 256 * j); g2[j] = *(const f32x4*)(p.in[15] + 4 * lane + 256 * j); }
    f32x4 nt[4], nxx[4];
    { const int m0 = gw < MR ? gw : 0; const float* xr0 = m0 < MP ? p.in[0] + (size_t)m0 * D : p.in[1] + (size_t)(m0 - MP) * D;
#pragma unroll
      for (int j = 0; j < 4; ++j) { { const u32x2 tb = *(const u32x2*)(T1 + (size_t)m0 * D + 4 * lane + 256 * j); nt[j] = (f32x4){bflo(tb.x), bfhi(tb.x), bflo(tb.y), bfhi(tb.y)}; } nxx[j] = *(const f32x4*)(xr0 + 4 * lane + 256 * j); } }
    for (int m = gw; m < MR; m += NGW) {
        f32x4 t[4], x[4]; float s = 0.f;
#pragma unroll
        for (int j = 0; j < 4; ++j) { t[j] = nt[j]; x[j] = nxx[j]; s += (t[j][0] * t[j][0] + t[j][1] * t[j][1]) + (t[j][2] * t[j][2] + t[j][3] * t[j][3]); }
        { const int mn = (m + NGW < MR) ? m + NGW : m; const float* xrn = mn < MP ? p.in[0] + (size_t)mn * D : p.in[1] + (size_t)(mn - MP) * D;
#pragma unroll
          for (int j = 0; j < 4; ++j) { { const u32x2 tb = *(const u32x2*)(T1 + (size_t)mn * D + 4 * lane + 256 * j); nt[j] = (f32x4){bflo(tb.x), bfhi(tb.x), bflo(tb.y), bfhi(tb.y)}; } nxx[j] = *(const f32x4*)(xrn + 4 * lane + 256 * j); } }
        const float rstd = 1.f / sqrtf(wave_sum(s) * (1.f / D) + EPS); float s2 = 0.f;
#pragma unroll
        for (int j = 0; j < 4; ++j) { x[j] = x[j] + t[j] * rstd * g1[j]; *(u32x2*)(X1B + (size_t)m * D + 4 * lane + 256 * j) = pk4(x[j]); s2 += (x[j][0] * x[j][0] + x[j][1] * x[j][1]) + (x[j][2] * x[j][2] + x[j][3] * x[j][3]); }
        const float rstd2 = 1.f / sqrtf(wave_sum(s2) * (1.f / D) + EPS);
#pragma unroll
        for (int j = 0; j < 4; ++j) *(u32x2*)(XN + (size_t)m * D + 4 * lane + 256 * j) = pk4(x[j] * rstd2 * g2[j]);
    }
}
DI void norm_rows_fin(const Params& p, int gw, int NGW, int lane) {
    asm volatile("" : "+v"(lane));
    const bf16* T2 = (const bf16*)(p.ws + WS_T2); const bf16* X1B = (const bf16*)(p.ws + WS_MIX);
    f32x4 g1[4];
#pragma unroll
    for (int j = 0; j < 4; ++j) g1[j] = *(const f32x4*)(p.in[18] + 4 * lane + 256 * j);
    f32x4 nt[4], nxx[4];
    { const int m0 = gw < MR ? gw : 0;
#pragma unroll
      for (int j = 0; j < 4; ++j) { { const u32x2 tb = *(const u32x2*)(T2 + (size_t)m0 * D + 4 * lane + 256 * j); nt[j] = (f32x4){bflo(tb.x), bfhi(tb.x), bflo(tb.y), bfhi(tb.y)}; } { const u32x2 xb = *(const u32x2*)(X1B + (size_t)m0 * D + 4 * lane + 256 * j); nxx[j] = (f32x4){bflo(xb.x), bfhi(xb.x), bflo(xb.y), bfhi(xb.y)}; } } }
    for (int m = gw; m < MR; m += NGW) {
        f32x4 t[4], x[4]; float s = 0.f;
#pragma unroll
        for (int j = 0; j < 4; ++j) { t[j] = nt[j]; x[j] = nxx[j]; s += (t[j][0] * t[j][0] + t[j][1] * t[j][1]) + (t[j][2] * t[j][2] + t[j][3] * t[j][3]); }
        { const int mn = (m + NGW < MR) ? m + NGW : m;
#pragma unroll
          for (int j = 0; j < 4; ++j) { { const u32x2 tb = *(const u32x2*)(T2 + (size_t)mn * D + 4 * lane + 256 * j); nt[j] = (f32x4){bflo(tb.x), bfhi(tb.x), bflo(tb.y), bfhi(tb.y)}; } { const u32x2 xb = *(const u32x2*)(X1B + (size_t)mn * D + 4 * lane + 256 * j); nxx[j] = (f32x4){bflo(xb.x), bfhi(xb.x), bflo(xb.y), bfhi(xb.y)}; } } }
        const float rstd = 1.f / sqrtf(wave_sum(s) * (1.f / D) + EPS);
#pragma unroll
        for (int j = 0; j < 4; ++j) *(f32x4*)(p.out + (size_t)m * D + 4 * lane + 256 * j) = x[j] + t[j] * rstd * g1[j];
    }
}

#define XB_TMO      128
#define XB_XCNT(j)  (256  + 64 * (j))
#define XB_XSUB(j)  (1280 + 64 * (j))
#define XB_XGEN(j)  (2304 + 64 * (j))
#define XB_TOP      3328
#define XB_TOPGEN   3392
#define XCD_BAR_WORDS 3456
#define XB_SPIN_CAP (1u << 18)

__device__ __forceinline__ unsigned xb_ld(unsigned* p)              { return __hip_atomic_load(p, __ATOMIC_RELAXED, __HIP_MEMORY_SCOPE_AGENT); }
__device__ __forceinline__ unsigned xb_add(unsigned* p, unsigned v) { return __hip_atomic_fetch_add(p, v, __ATOMIC_RELAXED, __HIP_MEMORY_SCOPE_AGENT); }
__device__ __forceinline__ unsigned xb_xcc_id() { return (unsigned)__builtin_amdgcn_s_getreg((3 << 11) | 20) & 0xFu; }
#define XB_SPIN(cond, bar) do { unsigned _sp = 0; while (cond) { __builtin_amdgcn_s_sleep(1); \
    if ((++_sp & 255u) == 0u) { if (xb_ld(&(bar)[XB_TMO])) break; if (_sp > XB_SPIN_CAP) { atomicAdd(&(bar)[XB_TMO], 1u); break; } } } } while (0)

struct XcdBarrier {
    unsigned* bar; unsigned x;
    volatile LAS unsigned* st;
};

__device__ __forceinline__ XcdBarrier xcd_barrier_post(unsigned* bar, volatile LAS unsigned* st) {
    XcdBarrier b; b.bar = bar; b.x = xb_xcc_id(); b.st = st;
    if (threadIdx.x == 0) (void)xb_add(&bar[XB_XCNT(b.x)], 1u);
    return b;
}
__device__ __forceinline__ void xcd_barrier_complete(unsigned* bar, unsigned x, unsigned& nloc, unsigned& nx) {
    const unsigned G = gridDim.x * gridDim.y * gridDim.z;
    unsigned sum, cnt, mine, sp = 0u;
    for (;;) {
        sum = 0u; cnt = 0u; mine = 0u;
#pragma unroll
        for (unsigned j = 0; j < 16; ++j) { const unsigned c = xb_ld(&bar[XB_XCNT(j)]); sum += c; cnt += (c > 0u) ? 1u : 0u; mine = (j == x) ? c : mine; }
        if (sum == G) break;
        __builtin_amdgcn_s_sleep(1);
        if ((++sp & 255u) == 0u) { if (xb_ld(&bar[XB_TMO])) break; if (sp > XB_SPIN_CAP) { atomicAdd(&bar[XB_TMO], 1u); break; } }
    }
    nloc = mine > 0u ? mine : 1u; nx = cnt > 0u ? cnt : 1u;
}

__device__ __forceinline__ void xcd_barrier(const XcdBarrier& b) {
    asm volatile("s_waitcnt vmcnt(0)" ::: "memory");
    __syncthreads();
    if (threadIdx.x == 0) {
        unsigned* bar = b.bar;
        __builtin_amdgcn_s_waitcnt(0);
        unsigned nloc = b.st[0], nx = b.st[1];
        if (nloc == 0u) { xcd_barrier_complete(bar, b.x, nloc, nx); b.st[0] = nloc; b.st[1] = nx; }
        const unsigned old = xb_add(&bar[XB_XSUB(b.x)], 1u);
        const unsigned gen = old / nloc;
        if (old + 1u == (gen + 1u) * nloc) {
            __builtin_amdgcn_fence(__ATOMIC_RELEASE, "agent");
            asm volatile("s_waitcnt vmcnt(0)" ::: "memory");
            const unsigned og = xb_add(&bar[XB_TOP], 1u);
            const unsigned tg = og / nx;
            if (og + 1u == (tg + 1u) * nx) xb_add(&bar[XB_TOPGEN], 1u);
            else XB_SPIN(xb_ld(&bar[XB_TOPGEN]) == tg, bar);
            __builtin_amdgcn_fence(__ATOMIC_ACQUIRE, "agent");
            xb_add(&bar[XB_XGEN(b.x)], 1u);
            asm volatile("s_waitcnt vmcnt(0)" ::: "memory");
        } else {
            XB_SPIN(xb_ld(&bar[XB_XGEN(b.x)]) == gen, bar);
            __builtin_amdgcn_fence(__ATOMIC_ACQUIRE, "agent");
            asm volatile("s_waitcnt vmcnt(0)" ::: "memory");
        }
    }
    __syncthreads();
}

struct StoreF32 { float* O; int ldc; DI void operator()(int r, int c, float v) const { O[(size_t)r * ldc + c] = v; } };
struct StoreBf16 { bf16* O; int ldc; DI void operator()(int r, int c, float v) const { O[(size_t)r * ldc + c] = (bf16)(pk2(v, 0.f) & 0xffffu); } };
struct StoreRelu2 { bf16* O; int ldc; DI void operator()(int r, int c, float v) const { const float a = fmaxf(v, 0.f); O[(size_t)r * ldc + c] = (bf16)(pk2(a * a, 0.f) & 0xffffu); } };
template <int TMT, int TNT, class Store>
DI void small_gemm_tile(const bf16* A, const bf16* Bt, int K, int row0, int col0, LAS float* part, int tid, int wid, int lane, const Store& st) {
    asm volatile("" : "+v"(tid), "+v"(lane));
    const int fr = lane & 15, fq = lane >> 4, ks = K >> 3;
    f32x4 acc[TMT][TNT];
#pragma unroll
    for (int m = 0; m < TMT; ++m)
#pragma unroll
        for (int n = 0; n < TNT; ++n) acc[m][n] = (f32x4){0.f, 0.f, 0.f, 0.f};
    const bf16* ap = A + (size_t)(row0 + fr) * K + wid * ks + 8 * fq;
    const bf16* bp = Bt + (size_t)(col0 + fr) * K + wid * ks + 8 * fq;
#pragma unroll 4
    for (int k = 0; k < ks; k += 32) {
        bf16x8 a[TMT], b[TNT];
#pragma unroll
        for (int m = 0; m < TMT; ++m) a[m] = *(const bf16x8*)(ap + (size_t)m * 16 * K + k);
#pragma unroll
        for (int n = 0; n < TNT; ++n) b[n] = *(const bf16x8*)(bp + (size_t)n * 16 * K + k);
#pragma unroll
        for (int m = 0; m < TMT; ++m)
#pragma unroll
            for (int n = 0; n < TNT; ++n) acc[m][n] = MFMA16(a[m], b[n], acc[m][n]);
    }
    constexpr int TM = TMT * 16, TN = TNT * 16;
#pragma unroll
    for (int m = 0; m < TMT; ++m)
#pragma unroll
        for (int n = 0; n < TNT; ++n)
#pragma unroll
            for (int i = 0; i < 4; ++i) part[(wid * TM + m * 16 + 4 * fq + i) * TN + n * 16 + fr] = acc[m][n][i];
    __syncthreads();
    for (int idx = tid; idx < TM * TN; idx += 512) { const int r = idx / TN, c = idx % TN; float v = 0.f;
#pragma unroll
        for (int w = 0; w < 8; ++w) v += part[(w * TM + r) * TN + c];
        st(row0 + r, col0 + c, v); }
    __syncthreads();
}

__global__ void __launch_bounds__(512, 2) fwd_megakernel(Params p) {
    extern __shared__ __attribute__((aligned(16))) unsigned char lds_raw[];
    LAS unsigned char* lds = (LAS unsigned char*)lds_raw;
    cg::grid_group grid = cg::this_grid();
    const int wid = __builtin_amdgcn_readfirstlane(threadIdx.x >> 6);
#define FRESH int tid = threadIdx.x; asm volatile("" : "+v"(tid)); int lane = tid & 63; (void)lane
    const int G = gridDim.x, bx = blockIdx.x;
    if (threadIdx.x < 16) ((LAS unsigned*)(lds + LDS_CTL))[threadIdx.x] = 0u;
    __syncthreads();
    XcdBarrier xbar = xcd_barrier_post((unsigned*)(p.ws + WS_BAR), (volatile LAS unsigned*)(lds + LDS_CTL));
#define GSYNC() do { if (p.use_cg) grid.sync(); else xcd_barrier(xbar); } while (0)
    const int gw = bx * 8 + wid, NGW = G * 8;
    unsigned char* ws = p.ws;
#ifndef PHM
#define PHM 0xFFFF
#endif
    { FRESH; if (PHM & 1) p0_prologue(p, lds, gw, NGW, wid, lane); }
    GSYNC();
    if (PHM & 2) { pg8::Gemm g{(const pg8::bf16_t*)(ws + WS_XN), (const pg8::bf16_t*)(ws + WS_WIN), MPAD, NIN, D}; pg8::StaticOrder S; S.init(MPAD, NIN, G, bx);
      pg8::EpiInProj E{(pg8::bf16_t*)(ws + WS_QA), (pg8::bf16_t*)(ws + WS_KV), (pg8::bf16_t*)(ws + WS_QG), (pg8::bf16_t*)(ws + WS_Z)};
      pg8::gemm_phase<pg8::EpiInProj, pg8::StaticOrder, true, true>(lds, g, S, E); }
    { FRESH; const int nfull = (MPAD / 256) * (NIN / 256) % G;
      if (nfull != 0 && bx >= nfull) late_transposes(p, lds, (bx - nfull) * 8 + wid, (G - nfull) * 8, wid, lane);
      else if (nfull == 0) late_transposes(p, lds, gw, NGW, wid, lane); }
    GSYNC();
    { FRESH; if ((G & 7) == 0) { const int per = G >> 3;
          for (int n = bx >> 3; n < 64; n += per) { if (PHM & 4) gdn_prep_unit(p, lds, (bx & 7) * 128 + n, tid, wid, lane); } }
      else for (int u = bx; u < 512; u += G) { if (PHM & 4) gdn_prep_unit(p, lds, (u >> 6) * 128 + (u & 63), tid, wid, lane); } }
    { FRESH; state_copies(p, bx * 512 + tid, G * 512); }
    GSYNC();
    { FRESH; if (bx < 64) { if (PHM & 32) scan_phase<0>(p, lds, bx, wid, lane); }
    else if ((G & 7) == 0) { const int per = (G - 64) >> 3;
        for (int n = (bx - 64) >> 3; n < 64; n += per) { if (PHM & 4) gdn_prep_unit(p, lds, (bx & 7) * 128 + 64 + n, tid, wid, lane); }
        if (G == 256 && bx >= 192) { if (PHM & 64) attn_unit(p, lds, bx - 192, tid, wid, lane); } }
    else for (int u = bx - 64; u < 512; u += G - 64) { if (PHM & 4) gdn_prep_unit(p, lds, (u >> 6) * 128 + 64 + (u & 63), tid, wid, lane); } }
    GSYNC();
    { FRESH; if (bx < 64) { if (PHM & 32) scan_phase<1>(p, lds, bx, wid, lane); }
    else { const int a0 = (G == 256) ? 64 : 0, na = 256 - a0;
      for (int u = bx - 64; u < na + 640; u += G - 64) {
        if (u < na) { if (PHM & 64) attn_unit(p, lds, a0 + u, tid, wid, lane); }
        else if (u < na + 512) { if (PHM & 8) sample_gdn_unit(p, lds, u - na, tid, wid, lane); }
        else { if (PHM & 16) sample_attn_unit(p, lds, u - na - 512, tid, wid, lane); } } } }
    GSYNC();
    { FRESH; if ((G & 7) == 0) { const int per = G >> 3;
          for (int j = bx >> 3; j < 64; j += per) { if (PHM & 128) gdn_out_pair(p, (bx & 7) * 64 + j, wid, lane); } }
      else for (int u = bx; u < 512; u += G) { if (PHM & 128) gdn_out_pair(p, u, wid, lane); } }
    GSYNC();
    if (PHM & 256) { pg8::Gemm g{(const pg8::bf16_t*)(ws + WS_MIX), (const pg8::bf16_t*)(ws + WS_WOUT), MP, D, D}; pg8::StaticOrder S; S.init(MP, D, G, bx);
      pg8::EpiBf16p E{(pg8::bf16_t*)(ws + WS_T1), D};
      pg8::gemm_phase<pg8::EpiBf16p, pg8::StaticOrder, true, true>(lds, g, S, E); }
    { FRESH; for (int t = bx; t < 256; t += G) small_gemm_tile<1, 2>((const bf16*)(ws + WS_MIX), (const bf16*)(ws + WS_WOUT), D, MP + (t >> 5) * 16, (t & 31) * 32, (LAS float*)lds, tid, wid, lane, StoreBf16{(bf16*)(ws + WS_T1), D}); }
    GSYNC();
    { FRESH; if (PHM & 512) norm_rows_mid(p, gw, NGW, lane); }
    GSYNC();
    if (PHM & 1024) { pg8::Gemm g{(const pg8::bf16_t*)(ws + WS_XN), (const pg8::bf16_t*)(ws + WS_WUP), MP, FF, D}; pg8::StaticOrder S; S.init(MP, FF, G, bx);
      pg8::EpiRelu2 E{(pg8::bf16_t*)(ws + WS_H), FF};
      pg8::gemm_phase<pg8::EpiRelu2, pg8::StaticOrder, true, true>(lds, g, S, E); }
    { FRESH; for (int t = bx; t < 256; t += G) small_gemm_tile<2, 4>((const bf16*)(ws + WS_XN), (const bf16*)(ws + WS_WUP), D, MP + (t >> 6) * 32, (t & 63) * 64, (LAS float*)lds, tid, wid, lane, StoreRelu2{(bf16*)(ws + WS_H), FF}); }
    GSYNC();
    if (PHM & 2048) { pg8::Gemm g{(const pg8::bf16_t*)(ws + WS_H), (const pg8::bf16_t*)(ws + WS_WDN), MP, D, FF}; pg8::StaticOrder S; S.init(MP, D, G, bx);
      pg8::EpiBf16p E{(pg8::bf16_t*)(ws + WS_T2), D};
      pg8::gemm_phase<pg8::EpiBf16p, pg8::StaticOrder, true, true>(lds, g, S, E); }
    { FRESH; for (int t = bx; t < 256; t += G) small_gemm_tile<1, 2>((const bf16*)(ws + WS_H), (const bf16*)(ws + WS_WDN), FF, MP + (t >> 5) * 16, (t & 31) * 32, (LAS float*)lds, tid, wid, lane, StoreBf16{(bf16*)(ws + WS_T2), D}); }
    GSYNC();
    { FRESH; if (PHM & 4096) norm_rows_fin(p, gw, NGW, lane); }
}

extern "C" void kernel_launch(void* const* d_in, const int* in_sizes, int n_in, void* d_out, int out_size, void* d_ws, size_t ws_size, hipStream_t stream) {
    static int grid = 0;
    if (grid == 0) {
        if (n_in != 19 || ws_size < WS_END) { fprintf(stderr, "kernel_launch: unexpected n_in %d / ws_size %zu\n", n_in, ws_size); grid = -1; return; }
        int dev = 0, cus = 0, per_cu = 0;
        hipGetDevice(&dev); hipDeviceGetAttribute(&cus, hipDeviceAttributeMultiprocessorCount, dev);
        if (hipFuncSetAttribute((const void*)fwd_megakernel, hipFuncAttributeMaxDynamicSharedMemorySize, LDS_BYTES) != hipSuccess) { fprintf(stderr, "kernel_launch: hipFuncSetAttribute failed\n"); }
        hipOccupancyMaxActiveBlocksPerMultiprocessor(&per_cu, (const void*)fwd_megakernel, 512, LDS_BYTES);
        (void)hipGetLastError();
        if (per_cu < 1) { fprintf(stderr, "kernel_launch: occupancy query says %d blocks/CU\n", per_cu); per_cu = 1; }
        grid = cus;
        if (grid < 65) { fprintf(stderr, "kernel_launch: grid %d too small\n", grid); grid = -1; return; }
    }
    if (grid < 0) return;
    Params p{};
    for (int i = 0; i < 19; ++i) p.in[i] = (const float*)d_in[i];
    p.out = (float*)d_out; p.ws = (unsigned char*)d_ws; p.use_cg = 0; p.pad = 0;
    (void)hipMemsetAsync((unsigned char*)d_ws + WS_BAR, 0, 16384, stream);
    void* args[] = {&p};
    hipError_t e = hipLaunchCooperativeKernel((const void*)fwd_megakernel, dim3(grid), dim3(512), args, LDS_BYTES, stream);
    if (e != hipSuccess) fprintf(stderr, "cooperative launch failed: %s (grid %d)\n", hipGetErrorString(e), grid);
}
```

```cpp
#include <hip/hip_runtime.h>
#include <hip/hip_cooperative_groups.h>
#include <cstdio>
#include <cstdint>
namespace cg = cooperative_groups;
namespace pg8 {
#define PG8_LAS __attribute__((address_space(3)))
typedef unsigned short bf16_t;
typedef short bf16x8 __attribute__((ext_vector_type(8)));
typedef float f32x4 __attribute__((ext_vector_type(4)));
typedef unsigned u32x4 __attribute__((ext_vector_type(4)));
constexpr int BM = 256, BK = 64, HALF = 128, HTB = HALF * BK * 2  , STAGE_BYTES = 8 * HTB, NXCD = 8, WGM = 8;

__host__ __device__ __forceinline__ int lds_byte(int r, int c) { const int st = (r >> 4) * 2 + (c >> 5), rr = r & 15, cc = c & 31, ob = rr * 64 + cc * 2; return st * 1024 + (ob ^ (((ob >> 9) & 1) << 5)); }
__host__ __device__ __forceinline__ void stage_rc(int b, int& R, int& C) { const int st = b / 1024, sb = b % 1024, swz = sb ^ (((sb >> 9) & 1) << 5); R = (st >> 1) * 16 + swz / 64; C = (st & 1) * 32 + (swz % 64) / 2; }
__host__ __device__ __forceinline__ int perm32(int rho) { const int n = rho >> 4, i = rho & 15; return 8 * (i >> 2) + 4 * n + (i & 3); }

struct Unit { int pm, pn; };
struct Gemm { const bf16_t* A; const bf16_t* Bt; int M, N, K; };

struct StaticOrder {
    int nM, nN, nwg, G, c;
    __host__ __device__ void init(int M, int N, int G_, int c_) { nM = M / BM; nN = N / BM; nwg = nM * nN; G = G_; c = c_; }
    __host__ __device__ bool next(int i, Unit& u) const {
        const long L = (long)i * G + c; if (L >= nwg) return false;
        int wgid = (int)L; { const int q = nwg / NXCD, r = nwg % NXCD, xcd = wgid % NXCD, off = wgid / NXCD; wgid = (xcd < r ? xcd * (q + 1) : r * (q + 1) + (xcd - r) * q) + off; }
        const int nig = WGM * nN, gid = wgid / nig, fm = gid * WGM, gsz = (nM - fm) < WGM ? (nM - fm) : WGM;
        u.pm = fm + ((wgid % nig) % gsz); u.pn = (wgid % nig) / gsz; return true;
    }
    __device__ __forceinline__ void a_ready(const Unit&) const {}
    __device__ __forceinline__ void done(const Unit&) const {}
};

typedef unsigned u32x2e __attribute__((ext_vector_type(2)));
typedef __bf16 bf2e_t __attribute__((ext_vector_type(2)));
typedef float f32x2e __attribute__((ext_vector_type(2)));
__device__ __forceinline__ unsigned cvt_pk_bf16(float lo, float hi) { f32x2e v = {lo, hi}; return __builtin_bit_cast(unsigned, __builtin_convertvector(v, bf2e_t)); }
struct EpiInProj {
    static constexpr bool PERM = true, AFTER_DRAIN = false;
    bf16_t *QA, *KV, *QG, *Z;
    __device__ __forceinline__ void operator()(const f32x4 (&acc)[2][2][4][2], const Unit& u, int wr, int wc, int fr, int fq) const {
        const int pn = u.pn; bf16_t* base; int ldc, colt;
        if (pn < 2) { base = QA; ldc = 512; colt = pn * 256; } else if (pn == 2) { base = KV; ldc = 256; colt = 0; } else if (pn < 9) { base = QG; ldc = 1536; colt = (pn - 3) * 256; } else { base = Z; ldc = 512; colt = (pn - 9) * 256; }
        const int row0 = u.pm * BM + wr * 64 + fr, col0 = colt + wc * 32 + 8 * fq;
#pragma unroll
        for (int ai = 0; ai < 2; ++ai)
#pragma unroll
            for (int m = 0; m < 4; ++m) { bf16_t* rowp = base + (size_t)(row0 + ai * HALF + m * 16) * ldc + col0;
#pragma unroll
                for (int bj = 0; bj < 2; ++bj) { const f32x4 v0 = acc[ai][bj][m][0], v1 = acc[ai][bj][m][1];
                    u32x4 w; w.x = cvt_pk_bf16(v0[0], v0[1]); w.y = cvt_pk_bf16(v0[2], v0[3]); w.z = cvt_pk_bf16(v1[0], v1[1]); w.w = cvt_pk_bf16(v1[2], v1[3]);
                    *(u32x4*)(rowp + bj * HALF) = w; } }
    }
};
struct EpiRelu2 {
    static constexpr bool PERM = true, AFTER_DRAIN = false;
    bf16_t* O; int ldc;
    __device__ __forceinline__ void operator()(const f32x4 (&acc)[2][2][4][2], const Unit& u, int wr, int wc, int fr, int fq) const {
        const int row0 = u.pm * BM + wr * 64 + fr, col0 = u.pn * BM + wc * 32 + 8 * fq;
#pragma unroll
        for (int ai = 0; ai < 2; ++ai)
#pragma unroll
            for (int m = 0; m < 4; ++m) { bf16_t* rowp = O + (size_t)(row0 + ai * HALF + m * 16) * ldc + col0;
#pragma unroll
                for (int bj = 0; bj < 2; ++bj) { f32x4 v0 = acc[ai][bj][m][0], v1 = acc[ai][bj][m][1];
#pragma unroll
                    for (int e = 0; e < 4; ++e) { const float a = fmaxf(v0[e], 0.f), b = fmaxf(v1[e], 0.f); v0[e] = a * a; v1[e] = b * b; }
                    u32x4 w; w.x = cvt_pk_bf16(v0[0], v0[1]); w.y = cvt_pk_bf16(v0[2], v0[3]); w.z = cvt_pk_bf16(v1[0], v1[1]); w.w = cvt_pk_bf16(v1[2], v1[3]);
                    *(u32x4*)(rowp + bj * HALF) = w; } }
    }
};
struct EpiBf16p {
    static constexpr bool PERM = true, AFTER_DRAIN = false;
    bf16_t* O; int ldc;
    __device__ __forceinline__ void operator()(const f32x4 (&acc)[2][2][4][2], const Unit& u, int wr, int wc, int fr, int fq) const {
        const int row0 = u.pm * BM + wr * 64 + fr, col0 = u.pn * BM + wc * 32 + 8 * fq;
#pragma unroll
        for (int ai = 0; ai < 2; ++ai)
#pragma unroll
            for (int m = 0; m < 4; ++m) { bf16_t* rowp = O + (size_t)(row0 + ai * HALF + m * 16) * ldc + col0;
#pragma unroll
                for (int bj = 0; bj < 2; ++bj) { f32x4 v0 = acc[ai][bj][m][0], v1 = acc[ai][bj][m][1];
                    u32x4 w; w.x = cvt_pk_bf16(v0[0], v0[1]); w.y = cvt_pk_bf16(v0[2], v0[3]); w.z = cvt_pk_bf16(v1[0], v1[1]); w.w = cvt_pk_bf16(v1[2], v1[3]);
                    *(u32x4*)(rowp + bj * HALF) = w; } }
    }
};
struct EpiF32 {
    static constexpr bool PERM = true, AFTER_DRAIN = false;
    float* O; int ldc;
    __device__ __forceinline__ void operator()(const f32x4 (&acc)[2][2][4][2], const Unit& u, int wr, int wc, int fr, int fq) const {
        const int row0 = u.pm * BM + wr * 64 + fr, col0 = u.pn * BM + wc * 32 + 8 * fq;
#pragma unroll
        for (int ai = 0; ai < 2; ++ai)
#pragma unroll
            for (int m = 0; m < 4; ++m) { float* rowp = O + (size_t)(row0 + ai * HALF + m * 16) * ldc + col0;
#pragma unroll
                for (int bj = 0; bj < 2; ++bj) { *(f32x4*)(rowp + bj * HALF) = acc[ai][bj][m][0]; *(f32x4*)(rowp + bj * HALF + 4) = acc[ai][bj][m][1]; } }
    }
};
template <class Epi, class Sched, bool ALIGN_EPI = false, bool SP2 = false>
__device__ __forceinline__ void gemm_phase(PG8_LAS unsigned char* lds, const Gemm g, const Sched& S, const Epi& E) {
    int tid_ = threadIdx.x; asm volatile("" : "+v"(tid_));
    const int tid = tid_, wid = __builtin_amdgcn_readfirstlane(tid >> 6), lane = tid & 63, wr = wid >> 2, wc = wid & 3, fr = lane & 15, fq = lane >> 4;
    const int K = g.K, nt = K / BK;
    unsigned voffA[2], voffB[2];
#pragma unroll
    for (int i = 0; i < 2; ++i) { int R, C; stage_rc(tid * 16 + i * 8192, R, C); const int Rb = Epi::PERM ? ((R & ~31) + perm32(R & 31)) : R;
        voffA[i] = (unsigned)(R * K + C) * 2u; voffB[i] = (unsigned)(Rb * K + C) * 2u; }
    const size_t kstep = (size_t)(BK * 2);
    const size_t hstep = (size_t)HALF * K * 2;
    const size_t tstep = 2 * hstep;
    const unsigned ldsw = (unsigned)wid * 1024u;
    const int aoff = lds_byte(wr * 64 + fr, fq * 8), boff = lds_byte(wc * 32 + fr, fq * 8);
#define PG8_SA(b, h) (((b) * 2 + (h)) * HTB)
#define PG8_SB(b, h) ((4 + (b) * 2 + (h)) * HTB)
#define PG8_STAGE(bufoff, gbase, voff) do { _Pragma("unroll") for (int _i = 0; _i < 2; ++_i) \
        __builtin_amdgcn_global_load_lds((const unsigned*)((const char*)(gbase) + (voff)[_i]), (PG8_LAS unsigned*)(lds + (bufoff) + ldsw + _i * 8192), 16, 0, 0); } while (0)
#define PG8_LDA(dst, b, h) do { _Pragma("unroll") for (int m = 0; m < 4; ++m) _Pragma("unroll") for (int k = 0; k < 2; ++k) dst[m][k] = *(const PG8_LAS bf16x8*)(lds + PG8_SA(b, h) + aoff + m * 2048 + k * 1024); } while (0)
#define PG8_LDB(dst, b, h) do { _Pragma("unroll") for (int n = 0; n < 2; ++n) _Pragma("unroll") for (int k = 0; k < 2; ++k) dst[n][k] = *(const PG8_LAS bf16x8*)(lds + PG8_SB(b, h) + boff + n * 2048 + k * 1024); } while (0)
#define PG8_MMA(ai, bj, At, Bt) do { __builtin_amdgcn_s_setprio(1); _Pragma("unroll") for (int m = 0; m < 4; ++m) _Pragma("unroll") for (int n = 0; n < 2; ++n) _Pragma("unroll") for (int k = 0; k < 2; ++k) \
        acc[ai][bj][m][n] = __builtin_amdgcn_mfma_f32_16x16x32_bf16(Bt[n][k], At[m][k], acc[ai][bj][m][n], 0, 0, 0); __builtin_amdgcn_s_setprio(0); } while (0)
#define PG8_WAIT_V(n) asm volatile("s_waitcnt vmcnt(" #n ")" ::: "memory")
#define PG8_WAIT_L(n) asm volatile("s_waitcnt lgkmcnt(" #n ")" ::: "memory")
#define PG8_BAR __builtin_amdgcn_s_barrier()
#define PG8_SCHED __builtin_amdgcn_sched_barrier(0)
    Unit cur, nxt; int ui = 0;
    if (!S.next(0, cur)) return;
    f32x4 acc[2][2][4][2];
#pragma unroll
    for (int a = 0; a < 2; ++a)
#pragma unroll
        for (int b = 0; b < 2; ++b)
#pragma unroll
            for (int m = 0; m < 4; ++m)
#pragma unroll
                for (int n = 0; n < 2; ++n) acc[a][b][m][n] = (f32x4){0.f, 0.f, 0.f, 0.f};
    bf16x8 At[4][2], B0[2][2], B1[2][2];
    const char* cA = (const char*)g.A + (size_t)cur.pm * tstep; const char* cB = (const char*)g.Bt + (size_t)cur.pn * tstep;
    S.a_ready(cur);
    if constexpr (SP2) {
        PG8_STAGE(PG8_SB(0, 0), cB, voffB); PG8_STAGE(PG8_SB(0, 1), cB + hstep, voffB); PG8_STAGE(PG8_SA(0, 0), cA, voffA); PG8_STAGE(PG8_SA(0, 1), cA + hstep, voffA);
        if (wr == 1) PG8_BAR;
        PG8_WAIT_V(2); PG8_BAR;
        PG8_STAGE(PG8_SB(1, 0), cB + kstep, voffB); PG8_STAGE(PG8_SA(1, 0), cA + kstep, voffA); PG8_STAGE(PG8_SB(1, 1), cB + hstep + kstep, voffB);
        PG8_WAIT_V(6); PG8_BAR;
    } else {
        PG8_STAGE(PG8_SB(0, 0), cB, voffB); PG8_STAGE(PG8_SA(0, 0), cA, voffA); PG8_STAGE(PG8_SB(0, 1), cB + hstep, voffB); PG8_STAGE(PG8_SA(0, 1), cA + hstep, voffA);
        if (wr == 1) PG8_BAR;
        PG8_WAIT_V(4); PG8_BAR;
        PG8_STAGE(PG8_SB(1, 0), cB + kstep, voffB); PG8_STAGE(PG8_SA(1, 0), cA + kstep, voffA); PG8_STAGE(PG8_SB(1, 1), cB + hstep + kstep, voffB);
        PG8_WAIT_V(6); PG8_BAR;
    }
    for (;;) {
        const bool has_next = S.next(ui + 1, nxt);
        const char* nA = has_next ? (const char*)g.A + (size_t)nxt.pm * tstep : cA; const char* nB = has_next ? (const char*)g.Bt + (size_t)nxt.pn * tstep : cB;
        for (int t = 0; t < nt; t += 2) {
            const bool last = (t == nt - 2);
            const char* a1 = cA + (size_t)(t + 1) * kstep;
            const char* a2 = last ? nA : cA + (size_t)(t + 2) * kstep; const char* b2 = last ? nB : cB + (size_t)(t + 2) * kstep;
            const char* a3 = a2 + kstep; const char* b3 = b2 + kstep;
            if (last && has_next) S.a_ready(nxt);
            if constexpr (SP2) {
            PG8_LDB(B0, 0, 0); PG8_LDB(B1, 0, 1); PG8_SCHED; PG8_LDA(At, 0, 0); PG8_STAGE(PG8_SA(1, 1), a1 + hstep, voffA);
            PG8_WAIT_V(8); PG8_WAIT_L(0); PG8_BAR; PG8_MMA(0, 0, At, B0); PG8_MMA(0, 1, At, B1); PG8_BAR; PG8_SCHED;
            PG8_LDA(At, 0, 1); PG8_STAGE(PG8_SB(0, 0), b2, voffB); PG8_STAGE(PG8_SB(0, 1), b2 + hstep, voffB); PG8_STAGE(PG8_SA(0, 0), a2, voffA);
            PG8_WAIT_V(8); PG8_WAIT_L(0); PG8_BAR; PG8_MMA(1, 0, At, B0); PG8_MMA(1, 1, At, B1); PG8_BAR; PG8_SCHED;
            PG8_LDB(B0, 1, 0); PG8_LDB(B1, 1, 1); PG8_SCHED; PG8_LDA(At, 1, 0); PG8_STAGE(PG8_SA(0, 1), a2 + hstep, voffA);
            PG8_WAIT_V(8); PG8_WAIT_L(0); PG8_BAR; PG8_MMA(0, 0, At, B0); PG8_MMA(0, 1, At, B1); PG8_BAR; PG8_SCHED;
            PG8_LDA(At, 1, 1); PG8_STAGE(PG8_SB(1, 0), b3, voffB); PG8_STAGE(PG8_SB(1, 1), b3 + hstep, voffB); PG8_STAGE(PG8_SA(1, 0), a3, voffA);
            PG8_WAIT_V(8); PG8_WAIT_L(0); PG8_BAR; PG8_MMA(1, 0, At, B0); PG8_MMA(1, 1, At, B1); PG8_BAR; PG8_SCHED;
            } else {
            PG8_LDB(B0, 0, 0); PG8_SCHED; PG8_LDA(At, 0, 0); PG8_STAGE(PG8_SA(1, 1), a1 + hstep, voffA);
            PG8_WAIT_L(8); PG8_BAR; PG8_WAIT_L(0); PG8_MMA(0, 0, At, B0); PG8_BAR; PG8_SCHED;
            PG8_LDB(B1, 0, 1); PG8_STAGE(PG8_SB(0, 0), b2, voffB);
            PG8_BAR; PG8_WAIT_L(0); PG8_MMA(0, 1, At, B1); PG8_BAR;
            PG8_LDA(At, 0, 1); PG8_STAGE(PG8_SA(0, 0), a2, voffA);
            PG8_BAR; PG8_WAIT_L(0); PG8_MMA(1, 0, At, B0); PG8_BAR; PG8_SCHED;
            PG8_STAGE(PG8_SB(0, 1), b2 + hstep, voffB);
            PG8_WAIT_V(6); PG8_BAR; PG8_MMA(1, 1, At, B1); PG8_BAR;
            PG8_LDB(B0, 1, 0); PG8_SCHED; PG8_LDA(At, 1, 0); PG8_STAGE(PG8_SA(0, 1), a2 + hstep, voffA);
            PG8_WAIT_L(8); PG8_BAR; PG8_WAIT_L(0); PG8_MMA(0, 0, At, B0); PG8_BAR; PG8_SCHED;
            PG8_LDB(B1, 1, 1); PG8_STAGE(PG8_SB(1, 0), b3, voffB);
            PG8_BAR; PG8_WAIT_L(0); PG8_MMA(0, 1, At, B1); PG8_BAR;
            PG8_LDA(At, 1, 1); PG8_STAGE(PG8_SA(1, 0), a3, voffA);
            PG8_BAR; PG8_WAIT_L(0); PG8_MMA(1, 0, At, B0); PG8_BAR; PG8_SCHED;
            PG8_STAGE(PG8_SB(1, 1), b3 + hstep, voffB);
            PG8_WAIT_V(6); PG8_BAR; PG8_MMA(1, 1, At, B1); PG8_BAR;
            }
        }
        if constexpr (ALIGN_EPI) { if (wr == 0) PG8_BAR; }
        if constexpr (!Epi::AFTER_DRAIN) { E(acc, cur, wr, wc, fr, fq); S.done(cur); }
        if (!has_next) break;
#pragma unroll
        for (int a = 0; a < 2; ++a)
#pragma unroll
            for (int b = 0; b < 2; ++b)
#pragma unroll
                for (int m = 0; m < 4; ++m)
#pragma unroll
                    for (int n = 0; n < 2; ++n) acc[a][b][m][n] = (f32x4){0.f, 0.f, 0.f, 0.f};
        cur = nxt; cA = nA; cB = nB; ++ui;
        if constexpr (ALIGN_EPI) { if (wr == 1) PG8_BAR; }
    }
    PG8_WAIT_V(0);
    if constexpr (!ALIGN_EPI) { if (wr == 0) PG8_BAR; }
    PG8_BAR;
    if constexpr (Epi::AFTER_DRAIN) { E.fused(acc, cur, wr, wc, fr, fq, lds, wid, lane); S.done(cur); }
#undef PG8_SA
#undef PG8_SB
#undef PG8_STAGE
#undef PG8_LDA
#undef PG8_LDB
#undef PG8_MMA
#undef PG8_WAIT_V
#undef PG8_WAIT_L
#undef PG8_BAR
#undef PG8_SCHED
}
}
#define LAS __attribute__((address_space(3)))
#define DI __device__ __forceinline__
typedef unsigned short bf16;
typedef short bf16x8 __attribute__((ext_vector_type(8)));
typedef float f32x4 __attribute__((ext_vector_type(4)));
typedef float f32x2 __attribute__((ext_vector_type(2)));
typedef unsigned u32x4 __attribute__((ext_vector_type(4)));
typedef unsigned u32x2 __attribute__((ext_vector_type(2)));
typedef __bf16 bf2_t __attribute__((ext_vector_type(2)));
#define MFMA16(a, b, c) __builtin_amdgcn_mfma_f32_16x16x32_bf16((a), (b), (c), 0, 0, 0)
DI unsigned pk2(float lo, float hi) { f32x2 v = {lo, hi}; return __builtin_bit_cast(unsigned, __builtin_convertvector(v, bf2_t)); }
DI u32x2 pk4(f32x4 v) { u32x2 r; r.x = pk2(v[0], v[1]); r.y = pk2(v[2], v[3]); return r; }
DI float bf2f(bf16 h) { return __uint_as_float((unsigned)h << 16); }
DI float bflo(unsigned u) { return __uint_as_float(u << 16); }
DI float bfhi(unsigned u) { return __uint_as_float(u & 0xffff0000u); }
DI float wave_sum(float v) {
#pragma unroll
    for (int o = 1; o < 64; o <<= 1) v += __shfl_xor(v, o);
    return v;
}
DI float siluf(float y) { return y / (1.f + __expf(-y)); }

constexpr int D = 1024, SEQ = 8192, MP = 16384, MS = 128, MR = MP + MS, MPAD = 16640, NIN = 2816, INW = 2824, FF = 4096;
constexpr float EPS = 1e-6f;
constexpr size_t MiB = 1u << 20;
constexpr size_t WS_LD = 0, WS_AB = 65536;
constexpr size_t WS_WIN = 1 * MiB, WS_WOUT = 7 * MiB, WS_WUP = 9 * MiB, WS_WDN = 17 * MiB;
constexpr size_t WS_XN = 25 * MiB, WS_QT = 25 * MiB, WS_OB = 41 * MiB, WS_MIX = 58 * MiB;
constexpr size_t WS_QA = 91 * MiB, WS_KV = 107 * MiB + 512 * 1024, WS_QG = 116 * MiB, WS_SG = 116 * MiB, WS_Z = 165 * MiB, WS_MP = 182 * MiB, WS_BST = 214 * MiB;
constexpr size_t WS_T1 = 91 * MiB, WS_H = 91 * MiB, WS_T2 = 25 * MiB, WS_END = 256 * MiB;
constexpr size_t O_Y = 0, O_PSC = 16908288, O_PCK = 16917504, O_PCV = 16950272, O_PSG = 16983040, O_SSC = 17114112, O_SCK = 17703936, O_SCV = 19801088, O_SSG = 21898240;
constexpr int LDS_CTL = 147456, LDS_XB = 147456 + 64, LDS_BYTES = 147456 + 64 + 8192;
constexpr size_t WS_BAR = 32768;

struct Params { const float* in[19]; float* out; unsigned char* ws; int use_cg, pad; };

DI void p0_transpose_item(const float* W, int ldw, int N, int K, bf16* WT, LAS float* scr, int item, int lane) {
    const int nblk = N / 32, kb = item / nblk, nb = item % nblk, k0 = 64 * kb, n0 = 32 * nb;
#pragma unroll 8
    for (int i = 0; i < 32; ++i) { const int kk = 2 * i + (lane >> 5); scr[kk * 33 + (lane & 31)] = W[(size_t)(k0 + kk) * ldw + n0 + (lane & 31)]; }
    asm volatile("s_waitcnt lgkmcnt(0)" ::: "memory");
    const int c = lane & 7;
#pragma unroll
    for (int j = 0; j < 4; ++j) { const int n = (lane >> 3) + 8 * j; const LAS float* s = scr + (8 * c) * 33 + n;
        u32x4 o; o.x = pk2(s[0 * 33], s[1 * 33]); o.y = pk2(s[2 * 33], s[3 * 33]); o.z = pk2(s[4 * 33], s[5 * 33]); o.w = pk2(s[6 * 33], s[7 * 33]);
        *(u32x4*)(WT + (size_t)(n0 + n) * K + k0 + 8 * c) = o; }
    asm volatile("s_waitcnt lgkmcnt(0)" ::: "memory");
}
DI void p0_prologue(const Params& p, LAS unsigned char* lds, int gw, int NGW, int wid, int lane) {
    asm volatile("" : "+v"(lane));
    LAS float* scr = (LAS float*)(lds + wid * 16384);
    unsigned char* ws = p.ws;
    constexpr int I_IN = (D / 64) * (NIN / 32);
    for (int it = gw; it < I_IN; it += NGW) p0_transpose_item(p.in[7], INW, NIN, D, (bf16*)(ws + WS_WIN), scr, it, lane);
    f32x4 wab[4][4][2];
    const float* win = p.in[7];
#pragma unroll
    for (int j = 0; j < 4; ++j)
#pragma unroll
        for (int e = 0; e < 4; ++e) { const float* wp = win + (size_t)(4 * lane + 256 * j + e) * INW + NIN; wab[j][e][0] = *(const f32x4*)wp; wab[j][e][1] = *(const f32x4*)(wp + 4); }
    f32x4 gv[4];
#pragma unroll
    for (int j = 0; j < 4; ++j) gv[j] = *(const f32x4*)(p.in[6] + 4 * lane + 256 * j);
    bf16* XN = (bf16*)(ws + WS_XN); float* AB = (float*)(ws + WS_AB);
    f32x4 nx[4];
    { const int m0 = gw < MR ? gw : 0; const float* xr0 = m0 < MP ? p.in[0] + (size_t)m0 * D : p.in[1] + (size_t)(m0 - MP) * D;
#pragma unroll
      for (int j = 0; j < 4; ++j) nx[j] = *(const f32x4*)(xr0 + 4 * lane + 256 * j); }
    for (int m = gw; m < MR; m += NGW) {
        f32x4 v[4]; float s = 0.f;
#pragma unroll
        for (int j = 0; j < 4; ++j) { v[j] = nx[j]; s += (v[j][0] * v[j][0] + v[j][1] * v[j][1]) + (v[j][2] * v[j][2] + v[j][3] * v[j][3]); }
        { const int mn = (m + NGW < MR) ? m + NGW : m; const float* xrn = mn < MP ? p.in[0] + (size_t)mn * D : p.in[1] + (size_t)(mn - MP) * D;
#pragma unroll
          for (int j = 0; j < 4; ++j) nx[j] = *(const f32x4*)(xrn + 4 * lane + 256 * j); }
        const float rstd = 1.f / sqrtf(wave_sum(s) * (1.f / D) + EPS);
        f32x4 a0 = {0.f, 0.f, 0.f, 0.f}, a1 = {0.f, 0.f, 0.f, 0.f};
#pragma unroll
        for (int j = 0; j < 4; ++j) { v[j] = v[j] * rstd * gv[j];
#pragma unroll
            for (int e = 0; e < 4; ++e) { a0 += wab[j][e][0] * v[j][e]; a1 += wab[j][e][1] * v[j][e]; }
            *(u32x2*)(XN + (size_t)m * D + 4 * lane + 256 * j) = pk4(v[j]); }
#pragma unroll
        for (int e = 0; e < 4; ++e) { a0[e] = wave_sum(a0[e]); a1[e] = wave_sum(a1[e]); }
        if (lane == 0) { *(f32x4*)(AB + (size_t)m * 8) = a0; *(f32x4*)(AB + (size_t)m * 8 + 4) = a1; }
    }
}

DI void late_transposes(const Params& p, LAS unsigned char* lds, int gw, int NGW, int wid, int lane) {
    asm volatile("" : "+v"(lane));
    LAS float* scr = (LAS float*)(lds + wid * 16384);
    unsigned char* ws = p.ws;
    constexpr int I_O = (D / 64) * (D / 32), I_U = (D / 64) * (FF / 32), I_D = (FF / 64) * (D / 32);
    for (int it = gw; it < I_O + I_U + I_D; it += NGW) {
        int r = it;
        if (r < I_O) { p0_transpose_item(p.in[13], D, D, D, (bf16*)(ws + WS_WOUT), scr, r, lane); continue; } r -= I_O;
        if (r < I_U) { p0_transpose_item(p.in[16], FF, FF, D, (bf16*)(ws + WS_WUP), scr, r, lane); continue; } r -= I_U;
        p0_transpose_item(p.in[17], D, D, FF, (bf16*)(ws + WS_WDN), scr, r, lane);
    }
}

DI bf16x8 ldfrag(const LAS bf16* base, int pitch, int r0, int k0, int fr, int fq) { return *(const LAS bf16x8*)(base + (r0 + fr) * pitch + k0 + 8 * fq); }

DI void gdn_prep_unit(const Params& p, LAS unsigned char* lds, int unit, int tid, int wid, int lane) {
    asm volatile("" : "+v"(tid), "+v"(lane));
    const int c = unit >> 7, n = unit & 127, b = c >> 2, h = c & 3;
    const int rowbase = b * SEQ + n * 64;
    const int fr = lane & 15, fq = lane >> 4;
    unsigned char* ws = p.ws;
    LAS bf16* q_rm = (LAS bf16*)(lds);
    LAS bf16* k_rm = (LAS bf16*)(lds + 17408);
    LAS float* Amat = (LAS float*)(lds + 34816);
    LAS bf16* UT = (LAS bf16*)(lds + 17408);
    LAS bf16* XT = (LAS bf16*)(lds + 54272);
    LAS bf16* kdT = (LAS bf16*)(lds + 91136);
    LAS bf16* Tinv = (LAS bf16*)(lds + 109568);
    LAS bf16* qk = (LAS bf16*)(lds + 118784);
    LAS float* sG = (LAS float*)(lds + 128000);
    LAS float* sBeta = sG + 64; LAS float* sEG = sG + 128; LAS float* sEKD = sG + 192; LAS float* sRS = sG + 256;
    LAS float* part = Amat;
    LAS bf16* T11T = (LAS bf16*)(lds + 130048); LAS bf16* A21b = (LAS bf16*)(lds + 132608); LAS bf16* PT = (LAS bf16*)(lds + 135168);
    const bf16* QG = (const bf16*)(ws + WS_QG);
    const float* AB = (const float*)(ws + WS_AB);
    if (wid == 7) {
        const float a = AB[(size_t)(rowbase + lane) * 8 + h], bb = AB[(size_t)(rowbase + lane) * 8 + 4 + h];
        const float xs = a + p.in[11][h];
        const float sp = fmaxf(xs, 0.f) + log1pf(__expf(-fabsf(xs)));
        const float g = -__expf(p.in[10][h]) * sp;
        float G = g;
#pragma unroll
        for (int o = 1; o < 64; o <<= 1) { const float t = __int_as_float(__builtin_amdgcn_ds_bpermute(((lane - o) & 63) << 2, __float_as_int(G))); if (lane >= o) G += t; }
        const float Gl = __int_as_float(__builtin_amdgcn_readlane(__float_as_int(G), 63));
        sG[lane] = G; sBeta[lane] = 1.f / (1.f + __expf(-bb)); sEG[lane] = __expf(G); sEKD[lane] = __expf(Gl - G);
        if (lane == 63) ((float*)(ws + WS_LD))[unit] = __expf(G);
    }
    float val[8][8];
    const int cgp = tid >> 3, tr = tid & 7, prt = cgp >> 4, d0 = (cgp & 15) * 8, t0 = tr * 8;
    if (tid < 384) {
        const int col = prt * 512 + h * 128 + d0;
        float w[4][8];
#pragma unroll
        for (int i = 0; i < 4; ++i) { const f32x4 w0 = *(const f32x4*)(p.in[9] + i * 1536 + col), w1 = *(const f32x4*)(p.in[9] + i * 1536 + col + 4);
#pragma unroll
            for (int e = 0; e < 4; ++e) { w[i][e] = w0[e]; w[i][4 + e] = w1[e]; } }
#pragma unroll
        for (int tt = 0; tt < 8; ++tt)
#pragma unroll
            for (int e = 0; e < 8; ++e) val[tt][e] = 0.f;
#pragma unroll
        for (int r = 0; r < 11; ++r) {
            const int tl = n * 64 + t0 + r - 3;
            u32x4 xv = {0u, 0u, 0u, 0u};
            if (tl >= 0) xv = *(const u32x4*)(QG + (size_t)(b * SEQ + tl) * 1536 + col);
            float x[8] = {bflo(xv.x), bfhi(xv.x), bflo(xv.y), bfhi(xv.y), bflo(xv.z), bfhi(xv.z), bflo(xv.w), bfhi(xv.w)};
#pragma unroll
            for (int i = 0; i < 4; ++i) { const int tt = r - i;
                if (tt >= 0 && tt < 8) {
#pragma unroll
                    for (int e = 0; e < 8; ++e) val[tt][e] += w[i][e] * x[e]; } }
        }
#pragma unroll
        for (int tt = 0; tt < 8; ++tt) { float s = 0.f;
#pragma unroll
            for (int e = 0; e < 8; ++e) { val[tt][e] = siluf(val[tt][e]); s += val[tt][e] * val[tt][e]; }
            if (prt < 2) part[(prt * 64 + t0 + tt) * 16 + (cgp & 15)] = s; }
    }
    __syncthreads();
    if (tid < 128) { float s = 0.f;
#pragma unroll
        for (int i = 0; i < 16; ++i) s += part[tid * 16 + ((i + tid) & 15)];
        sRS[tid] = (tid < 64 ? 0.08838834764831845f : 1.f) / sqrtf(s + EPS); }
    __syncthreads();
    if (tid < 384) {
        if (prt == 0) {
#pragma unroll
            for (int tt = 0; tt < 8; ++tt) { const float r = sRS[t0 + tt]; u32x4 o; o.x = pk2(val[tt][0] * r, val[tt][1] * r); o.y = pk2(val[tt][2] * r, val[tt][3] * r); o.z = pk2(val[tt][4] * r, val[tt][5] * r); o.w = pk2(val[tt][6] * r, val[tt][7] * r);
                *(LAS u32x4*)(q_rm + (t0 + tt) * 136 + d0) = o; }
        } else if (prt == 1) {
            float be[8], kd[8];
#pragma unroll
            for (int tt = 0; tt < 8; ++tt) { const float r = sRS[64 + t0 + tt]; be[tt] = sBeta[t0 + tt] * sEG[t0 + tt]; kd[tt] = sEKD[t0 + tt];
#pragma unroll
                for (int e = 0; e < 8; ++e) val[tt][e] *= r;
                u32x4 o; o.x = pk2(val[tt][0], val[tt][1]); o.y = pk2(val[tt][2], val[tt][3]); o.z = pk2(val[tt][4], val[tt][5]); o.w = pk2(val[tt][6], val[tt][7]);
                *(LAS u32x4*)(k_rm + (t0 + tt) * 136 + d0) = o; }
#pragma unroll
            for (int e = 0; e < 8; ++e) { u32x4 o, o2;
                o.x = pk2(val[0][e] * be[0], val[1][e] * be[1]); o.y = pk2(val[2][e] * be[2], val[3][e] * be[3]); o.z = pk2(val[4][e] * be[4], val[5][e] * be[5]); o.w = pk2(val[6][e] * be[6], val[7][e] * be[7]);
                o2.x = pk2(val[0][e] * kd[0], val[1][e] * kd[1]); o2.y = pk2(val[2][e] * kd[2], val[3][e] * kd[3]); o2.z = pk2(val[4][e] * kd[4], val[5][e] * kd[5]); o2.w = pk2(val[6][e] * kd[6], val[7][e] * kd[7]);
                *(LAS u32x4*)(XT + (128 + d0 + e) * 72 + t0) = o; *(LAS u32x4*)(kdT + (d0 + e) * 72 + t0) = o2; }
        } else {
            float be[8];
#pragma unroll
            for (int tt = 0; tt < 8; ++tt) be[tt] = sBeta[t0 + tt];
#pragma unroll
            for (int e = 0; e < 8; ++e) { u32x4 o;
                o.x = pk2(val[0][e] * be[0], val[1][e] * be[1]); o.y = pk2(val[2][e] * be[2], val[3][e] * be[3]); o.z = pk2(val[4][e] * be[4], val[5][e] * be[5]); o.w = pk2(val[6][e] * be[6], val[7][e] * be[7]);
                *(LAS u32x4*)(XT + (d0 + e) * 72 + t0) = o; }
        }
    }
    __syncthreads();
#pragma unroll
    for (int q = 0; q < 2; ++q) { const int idx = wid + 8 * q, it = idx >> 2, jt = idx & 3;
        if (jt <= it) { f32x4 acc = {0.f, 0.f, 0.f, 0.f};
#pragma unroll
            for (int s = 0; s < 4; ++s) acc = MFMA16(ldfrag(k_rm, 136, it * 16, 32 * s, fr, fq), ldfrag(k_rm, 136, jt * 16, 32 * s, fr, fq), acc);
            const int j = jt * 16 + fr; const float Gj = sG[j];
#pragma unroll
            for (int i2 = 0; i2 < 4; ++i2) { const int i = it * 16 + 4 * fq + i2; const float av = sBeta[i] * acc[i2] * __expf(fminf(sG[i] - Gj, 0.f)); Amat[i * 68 + j] = av;
                if (it >= 2 && jt < 2) A21b[(i - 32) * 40 + j] = (bf16)(pk2(av, 0.f) & 0xffffu); } } }
    __syncthreads();
    if (wid < 2) {
#ifndef NOINV
        const int o = 32 * wid, cl = lane & 31;
        float T[32];
#pragma unroll
        for (int i = 0; i < 32; ++i) { float a = (i == cl) ? 1.f : 0.f;
#pragma unroll
            for (int jg = 0; jg < (i + 3) / 4; ++jg) { const f32x4 av = *(const LAS f32x4*)(Amat + (o + i) * 68 + o + 4 * jg);
#pragma unroll
                for (int e = 0; e < 4; ++e) if (4 * jg + e < i) a -= av[e] * T[4 * jg + e]; }
            T[i] = a; }
        if (lane < 32) {
#pragma unroll
            for (int i = 0; i < 32; i += 2) { const unsigned pk = pk2(T[i], T[i + 1]); Tinv[(o + i) * 72 + o + cl] = (bf16)(pk & 0xffffu); Tinv[(o + i + 1) * 72 + o + cl] = (bf16)(pk >> 16); }
            if (wid == 0) {
#pragma unroll
                for (int i = 0; i < 32; i += 8) { u32x4 w; w.x = pk2(T[i], T[i + 1]); w.y = pk2(T[i + 2], T[i + 3]); w.z = pk2(T[i + 4], T[i + 5]); w.w = pk2(T[i + 6], T[i + 7]); *(LAS u32x4*)(T11T + cl * 40 + i) = w; } }
        } else if (wid == 0) {
#pragma unroll
            for (int i = 0; i < 32; ++i) Tinv[i * 72 + 32 + cl] = 0;
        }
#endif
    } else {
        for (int idx = wid - 2; idx < 16; idx += 6) { const int it = idx >> 2, jt = idx & 3;
            f32x4 acc = {0.f, 0.f, 0.f, 0.f};
            if (jt <= it) {
#pragma unroll
                for (int s = 0; s < 4; ++s) acc = MFMA16(ldfrag(k_rm, 136, jt * 16, 32 * s, fr, fq), ldfrag(q_rm, 136, it * 16, 32 * s, fr, fq), acc);
                const int i = it * 16 + fr; const float Gi = sG[i];
#pragma unroll
                for (int i2 = 0; i2 < 4; ++i2) { const int j = jt * 16 + 4 * fq + i2; acc[i2] = (i >= j) ? acc[i2] * __expf(fminf(Gi - sG[j], 0.f)) : 0.f; } }
            *(LAS u32x2*)(qk + (it * 16 + fr) * 72 + jt * 16 + 4 * fq) = pk4(acc); }
    }
    __syncthreads();
    if (wid == 0) {
#pragma unroll
        for (int jt = 0; jt < 2; ++jt) { const bf16x8 yv = *(const LAS bf16x8*)(T11T + (jt * 16 + fr) * 40 + 8 * fq);
#pragma unroll
            for (int it = 0; it < 2; ++it) { f32x4 a = {0.f, 0.f, 0.f, 0.f}; a = MFMA16(*(const LAS bf16x8*)(A21b + (it * 16 + fr) * 40 + 8 * fq), yv, a);
                *(LAS u32x2*)(PT + (jt * 16 + fr) * 40 + it * 16 + 4 * fq) = pk4(a); } }
        asm volatile("s_waitcnt lgkmcnt(0)" ::: "memory");
#pragma unroll
        for (int jt = 0; jt < 2; ++jt) { const bf16x8 yv = *(const LAS bf16x8*)(PT + (jt * 16 + fr) * 40 + 8 * fq);
#pragma unroll
            for (int it = 0; it < 2; ++it) { f32x4 a = {0.f, 0.f, 0.f, 0.f}; a = MFMA16(*(const LAS bf16x8*)(Tinv + (32 + it * 16 + fr) * 72 + 32 + 8 * fq), yv, a);
                const u32x2 w = pk4(-a); const int j = jt * 16 + fr, i0 = 32 + it * 16 + 4 * fq;
                Tinv[i0 * 72 + j] = (bf16)(w.x & 0xffffu); Tinv[(i0 + 1) * 72 + j] = (bf16)(w.x >> 16); Tinv[(i0 + 2) * 72 + j] = (bf16)(w.y & 0xffffu); Tinv[(i0 + 3) * 72 + j] = (bf16)(w.y >> 16); } }
    }
    __syncthreads();
    { int t2 = threadIdx.x; asm volatile("" : "+v"(t2)); lane = t2 & 63; }
    const int fr3 = lane & 15, fq3 = lane >> 4;
#pragma unroll
    for (int q = 0; q < 2; ++q) { const int ft = 2 * wid + q;
        const bf16x8 y0 = ldfrag(XT, 72, ft * 16, 0, fr3, fq3), y1 = ldfrag(XT, 72, ft * 16, 32, fr3, fq3);
        f32x4 acc[4];
#pragma unroll
        for (int ct = 0; ct < 4; ++ct) { acc[ct] = (f32x4){0.f, 0.f, 0.f, 0.f}; acc[ct] = MFMA16(ldfrag(Tinv, 72, ct * 16, 0, fr3, fq3), y0, acc[ct]); acc[ct] = MFMA16(ldfrag(Tinv, 72, ct * 16, 32, fr3, fq3), y1, acc[ct]); }
#pragma unroll
        for (int ct = 0; ct < 4; ++ct) *(LAS u32x2*)(UT + (ft * 16 + fr3) * 72 + ct * 16 + 4 * fq3) = pk4(acc[ct]); }
    __syncthreads();
    {
        bf16* MPo = (bf16*)(ws + WS_MP) + (size_t)unit * 16384;
        bf16* BSo = (bf16*)(ws + WS_BST) + (size_t)unit * 16384;
        bf16* QTo = (bf16*)(ws + WS_QT) + (size_t)unit * 8192;
        bf16* OBo = (bf16*)(ws + WS_OB) + (size_t)unit * 8192;
        const bf16x8 w0 = ldfrag(UT, 72, 128 + wid * 16, 0, fr3, fq3), w1 = ldfrag(UT, 72, 128 + wid * 16, 32, fr3, fq3);
        const bf16x8 kd0 = ldfrag(kdT, 72, wid * 16, 0, fr3, fq3), kd1 = ldfrag(kdT, 72, wid * 16, 32, fr3, fq3);
        const bf16x8 u0 = ldfrag(UT, 72, wid * 16, 0, fr3, fq3), u1 = ldfrag(UT, 72, wid * 16, 32, fr3, fq3);
#pragma unroll
        for (int dt = 0; dt < 8; ++dt) {
            f32x4 a = {0.f, 0.f, 0.f, 0.f};
            a = MFMA16(w0, ldfrag(kdT, 72, dt * 16, 0, fr3, fq3), a); a = MFMA16(w1, ldfrag(kdT, 72, dt * 16, 32, fr3, fq3), a);
            const int s = wid >> 1, jb = (wid & 1) * 4, blk = dt * 4 + s;
            *(u32x2*)(MPo + ((size_t)(blk * 64 + lane) * 8 + jb)) = pk4(-a);
            f32x4 bacc = {0.f, 0.f, 0.f, 0.f};
            bacc = MFMA16(kd0, ldfrag(UT, 72, dt * 16, 0, fr3, fq3), bacc); bacc = MFMA16(kd1, ldfrag(UT, 72, dt * 16, 32, fr3, fq3), bacc);
            *(u32x2*)(BSo + ((size_t)((dt * 8 + wid) * 64 + lane) * 4)) = pk4(bacc);
        }
#pragma unroll
        for (int ct = 0; ct < 4; ++ct) {
            const bf16x8 y0 = ldfrag(qk, 72, ct * 16, 0, fr3, fq3), y1 = ldfrag(qk, 72, ct * 16, 32, fr3, fq3);
            f32x4 a = {0.f, 0.f, 0.f, 0.f}; a = MFMA16(w0, y0, a); a = MFMA16(w1, y1, a);
            const int cc = ct * 16 + fr3, dd = wid * 16 + 4 * fq3; const float eg = sEG[cc];
            const u32x2 qv = *(const LAS u32x2*)(q_rm + cc * 136 + dd);
            f32x4 o; o[0] = bflo(qv.x) * eg - a[0]; o[1] = bfhi(qv.x) * eg - a[1]; o[2] = bflo(qv.y) * eg - a[2]; o[3] = bfhi(qv.y) * eg - a[3];
            *(u32x2*)(QTo + cc * 128 + dd) = pk4(o);
            f32x4 ob = {0.f, 0.f, 0.f, 0.f}; ob = MFMA16(u0, y0, ob); ob = MFMA16(u1, y1, ob);
            *(u32x2*)(OBo + cc * 128 + dd) = pk4(ob);
        }
    }
    __syncthreads();
}
DI void scan_issue(const char* MPc, const char* BSc, LAS unsigned char* lds, int n, int lw, int lane) {
    const int slot = n & 3;
#pragma unroll
    for (int q = 0; q < 9; ++q) { const int blk = lw * 9 + q;
        const char* src = blk < 32 ? MPc + (size_t)n * 32768 + blk * 1024 : BSc + (size_t)n * 32768 + (blk - 32) * 1024;
        __builtin_amdgcn_global_load_lds((const unsigned*)(src + lane * 16), (LAS unsigned*)(lds + slot * 36864 + blk * 1024), 16, 0, 0); }
}
constexpr int PFD = 64;
template <int PART> DI void scan_phase(const Params& p, LAS unsigned char* lds, int wg, int wid, int lane) {
    constexpr int N0 = PART * 64, N1 = N0 + 64;
    asm volatile("" : "+v"(lane));
    const int c = wg & 7, sl = wg >> 3, fr = lane & 15, fq = lane >> 4, e0 = sl * 16;
    unsigned char* ws = p.ws;
    const char* MPc = (const char*)(ws + WS_MP) + (size_t)c * 128 * 32768;
    const char* BSc = (const char*)(ws + WS_BST) + (size_t)c * 128 * 32768 + sl * 4096;
    bf16* SGc = (bf16*)p.out + (size_t)c * 128 * 16384;
    const float* LD = (const float*)(ws + WS_LD) + c * 128;
    const bool loader = (wid >= 1 && wid <= 4); const int lw = wid - 1;
    unsigned pfdummy = 0u;
    f32x4 acc[8];
#pragma unroll
    for (int t = 0; t < 8; ++t) acc[t] = (f32x4){0.f, 0.f, 0.f, 0.f};
    float ldv0 = 0.f;
    if (wid == 0) { ldv0 = LD[N0 + lane];
        if (PART == 1) {
#pragma unroll
            for (int t = 0; t < 8; ++t) acc[t] = *(const LAS f32x4*)(lds + LDS_XB + (t * 64 + lane) * 16); } }
    if (loader) { scan_issue(MPc, BSc, lds, N0, lw, lane); scan_issue(MPc, BSc, lds, N0 + 1, lw, lane); scan_issue(MPc, BSc, lds, N0 + 2, lw, lane); asm volatile("s_waitcnt vmcnt(18)" ::: "memory"); }
    __builtin_amdgcn_s_barrier(); asm volatile("" ::: "memory");
    for (int n = N0; n < N1; ++n) {
        if (loader) { if (n + 3 < N1) { scan_issue(MPc, BSc, lds, n + 3, lw, lane); asm volatile("s_waitcnt vmcnt(18)" ::: "memory"); } else { asm volatile("s_waitcnt vmcnt(0)" ::: "memory"); } }
        if (wid == 5 && n + PFD < N1) {
            const char* pm = MPc + (size_t)(n + PFD) * 32768 + lane * 128; const char* pb = BSc + (size_t)(n + PFD) * 32768 + (lane & 31) * 128;
            asm volatile("global_load_dword %0, %1, off\n\tglobal_load_dword %0, %2, off\n\tglobal_load_dword %0, %3, off\n\tglobal_load_dword %0, %4, off\n\tglobal_load_dword %0, %5, off" : "+v"(pfdummy) : "v"(pm), "v"(pm + 8192), "v"(pm + 16384), "v"(pm + 24576), "v"(pb) : "memory");
        }
        if (wid == 0) {
            const LAS unsigned char* slot = lds + (n & 3) * 36864;
            bf16x8 mf[8][4];
#pragma unroll
            for (int m = 0; m < 4; ++m)
#pragma unroll
                for (int s = 0; s < 4; ++s) mf[m][s] = *(const LAS bf16x8*)(slot + (m * 4 + s) * 1024 + lane * 16);
            __builtin_amdgcn_sched_barrier(0);
            const float ld = __int_as_float(__builtin_amdgcn_readlane(__float_as_int(ldv0), n & 63));
            u32x2 pk[8];
#pragma unroll
            for (int t = 0; t < 8; ++t) { pk[t] = pk4(acc[t]); *(u32x2*)(SGc + (size_t)n * 16384 + (e0 + fr) * 128 + 16 * t + 4 * fq) = pk[t]; }
            bf16x8 Sb[4];
#pragma unroll
            for (int s = 0; s < 4; ++s) { u32x4 v; v.x = pk[2 * s].x; v.y = pk[2 * s].y; v.z = pk[2 * s + 1].x; v.w = pk[2 * s + 1].y; Sb[s] = __builtin_bit_cast(bf16x8, v); }
#pragma unroll
            for (int t = 0; t < 8; ++t) { const u32x2 bb = *(const LAS u32x2*)(slot + 32768 + t * 512 + lane * 8);
                acc[t][0] = ld * acc[t][0] + bflo(bb.x); acc[t][1] = ld * acc[t][1] + bfhi(bb.x); acc[t][2] = ld * acc[t][2] + bflo(bb.y); acc[t][3] = ld * acc[t][3] + bfhi(bb.y); }
            __builtin_amdgcn_sched_barrier(0);
#pragma unroll
            for (int m = 4; m < 8; ++m)
#pragma unroll
                for (int s = 0; s < 4; ++s) mf[m][s] = *(const LAS bf16x8*)(slot + (m * 4 + s) * 1024 + lane * 16);
            __builtin_amdgcn_sched_barrier(0);
#pragma unroll
            for (int s = 0; s < 4; ++s)
#pragma unroll
                for (int m = 0; m < 4; ++m) acc[m] = MFMA16(mf[m][s], Sb[s], acc[m]);
            __builtin_amdgcn_sched_barrier(0);
#pragma unroll
            for (int s = 0; s < 4; ++s)
#pragma unroll
                for (int m = 4; m < 8; ++m) acc[m] = MFMA16(mf[m][s], Sb[s], acc[m]);
            asm volatile("s_waitcnt lgkmcnt(0)" ::: "memory");
        }
        __builtin_amdgcn_s_barrier(); asm volatile("" ::: "memory");
    }
    if (wid == 0 && PART == 0) {
#pragma unroll
        for (int t = 0; t < 8; ++t) *(LAS f32x4*)(lds + LDS_XB + (t * 64 + lane) * 16) = acc[t]; }
    if (wid == 0 && PART == 1) { float* So = p.out + O_PSG + (size_t)c * 16384;
#pragma unroll
        for (int t = 0; t < 8; ++t)
#pragma unroll
            for (int i = 0; i < 4; ++i) So[(16 * t + 4 * fq + i) * 128 + e0 + fr] = acc[t][i]; }
    asm volatile("s_waitcnt vmcnt(0)" : "+v"(pfdummy) :: "memory");
    __syncthreads();
}

DI void attn_unit(const Params& p, LAS unsigned char* lds, int unit, int tid, int wid, int lane) {
    asm volatile("" : "+v"(tid), "+v"(lane));
    const int kvh = unit & 1, nb = (unit >> 1) & 63, b = unit >> 7;
    const int fr = lane & 15, fq = lane >> 4;
    unsigned char* ws = p.ws;
    const bf16* QA = (const bf16*)(ws + WS_QA); const bf16* KV = (const bf16*)(ws + WS_KV); bf16* MIX = (bf16*)(ws + WS_MIX);
    LAS bf16* Ks = (LAS bf16*)lds;
    LAS bf16* Vt = (LAS bf16*)(lds + 36864);
    const int tok0 = b * SEQ + 128 * (nb - 1);
    for (int it = tid; it < 2048; it += 512) { const int key = it >> 3, ch = it & 7;
        u32x4 kv = {0u, 0u, 0u, 0u}, vv = {0u, 0u, 0u, 0u};
        if (nb > 0 || key >= 128) { const bf16* src = KV + (size_t)(tok0 + key) * 256 + kvh * 64 + ch * 8; kv = *(const u32x4*)src; vv = *(const u32x4*)(src + 128); }
        *(LAS u32x4*)(Ks + key * 72 + ch * 8) = kv;
        LAS bf16* vd = Vt + (ch * 8) * 280 + key;
        vd[0] = (bf16)(vv.x & 0xffffu); vd[280] = (bf16)(vv.x >> 16); vd[560] = (bf16)(vv.y & 0xffffu); vd[840] = (bf16)(vv.y >> 16);
        vd[1120] = (bf16)(vv.z & 0xffffu); vd[1400] = (bf16)(vv.z >> 16); vd[1680] = (bf16)(vv.w & 0xffffu); vd[1960] = (bf16)(vv.w >> 16); }
    for (int it = tid; it < 64 * 24; it += 512) Vt[(it / 24) * 280 + 256 + (it % 24)] = 0;
    __syncthreads();
    const int g = wid >> 1, h = kvh * 4 + g, qh = wid & 1;
    const float slope = exp2f(-(float)(h + 1)), sink = p.in[8][h];
    for (int qt = 0; qt < 4; ++qt) {
        const int q0 = 64 * qh + 16 * qt;
        const size_t qrow = (size_t)(b * SEQ + 128 * nb + q0 + fr);
        const bf16x8 qf0 = *(const bf16x8*)(QA + qrow * 512 + h * 64 + 8 * fq), qf1 = *(const bf16x8*)(QA + qrow * 512 + h * 64 + 32 + 8 * fq);
        f32x4 sc[10]; float mx = sink;
#pragma unroll
        for (int kt = 0; kt < 9; ++kt) { const int ks0 = q0 + 16 * kt;
            f32x4 a = {0.f, 0.f, 0.f, 0.f};
            a = MFMA16(ldfrag(Ks, 72, ks0, 0, fr, fq), qf0, a); a = MFMA16(ldfrag(Ks, 72, ks0, 32, fr, fq), qf1, a);
#pragma unroll
            for (int i = 0; i < 4; ++i) { const int si = ks0 + 4 * fq + i, dist = 128 + q0 + fr - si;
                const bool ok = (dist >= 0) && (dist <= 128) && (nb > 0 || si >= 128);
                a[i] = ok ? a[i] * 0.125f - slope * (float)dist : -INFINITY; mx = fmaxf(mx, a[i]); }
            sc[kt] = a; }
        mx = fmaxf(mx, __shfl_xor(mx, 16)); mx = fmaxf(mx, __shfl_xor(mx, 32));
        float sum = 0.f;
#pragma unroll
        for (int kt = 0; kt < 9; ++kt)
#pragma unroll
            for (int i = 0; i < 4; ++i) { const float e = __expf(sc[kt][i] - mx); sc[kt][i] = e; sum += e; }
        sc[9] = (f32x4){0.f, 0.f, 0.f, 0.f};
        sum += __shfl_xor(sum, 16); sum += __shfl_xor(sum, 32);
        const float inv = 1.f / (sum + __expf(sink - mx));
        f32x4 o[4];
#pragma unroll
        for (int dt = 0; dt < 4; ++dt) o[dt] = (f32x4){0.f, 0.f, 0.f, 0.f};
#pragma unroll
        for (int s2 = 0; s2 < 5; ++s2) { const u32x2 p0 = pk4(sc[2 * s2]), p1 = pk4(sc[2 * s2 + 1]);
            u32x4 pv; pv.x = p0.x; pv.y = p0.y; pv.z = p1.x; pv.w = p1.y; const bf16x8 pb = __builtin_bit_cast(bf16x8, pv);
#pragma unroll
            for (int dt = 0; dt < 4; ++dt) { const LAS bf16* vp = Vt + (dt * 16 + fr) * 280 + q0 + 32 * s2 + 4 * fq;
                const u32x2 va = *(const LAS u32x2*)vp, vb = *(const LAS u32x2*)(vp + 16);
                u32x4 vv; vv.x = va.x; vv.y = va.y; vv.z = vb.x; vv.w = vb.y;
                o[dt] = MFMA16(__builtin_bit_cast(bf16x8, vv), pb, o[dt]); } }
#pragma unroll
        for (int dt = 0; dt < 4; ++dt) *(u32x2*)(MIX + qrow * 1024 + h * 64 + dt * 16 + 4 * fq) = pk4(o[dt] * inv);
    }
    __syncthreads();
}

DI void gdn_out_pair(const Params& p, int pair, int wid, int lane) {
    asm volatile("" : "+v"(lane));
    const int unit = pair * 2 + (wid >> 2), ct = wid & 3;
    const int c = unit >> 7, n = unit & 127, b = c >> 2, h = c & 3, fr = lane & 15, fq = lane >> 4;
    unsigned char* ws = p.ws;
    const bf16* QTo = (const bf16*)(ws + WS_QT) + (size_t)unit * 8192;
    const bf16* OBo = (const bf16*)(ws + WS_OB) + (size_t)unit * 8192;
    const bf16* SGo = (const bf16*)p.out + (size_t)unit * 16384;
    const int tokc = ct * 16 + fr; const size_t row = (size_t)(b * SEQ + n * 64 + tokc);
    bf16x8 qf[4];
#pragma unroll
    for (int s = 0; s < 4; ++s) qf[s] = *(const bf16x8*)(QTo + tokc * 128 + 32 * s + 8 * fq);
    u32x2 obv[8], zv[8];
#pragma unroll
    for (int t = 0; t < 8; ++t) { obv[t] = *(const u32x2*)(OBo + tokc * 128 + 16 * t + 4 * fq); zv[t] = *(const u32x2*)((const bf16*)(ws + WS_Z) + row * 512 + h * 128 + 16 * t + 4 * fq); }
    bf16x8 sf[8][4];
#pragma unroll
    for (int t = 0; t < 8; ++t)
#pragma unroll
        for (int s = 0; s < 4; ++s) sf[t][s] = *(const bf16x8*)(SGo + (16 * t + fr) * 128 + 32 * s + 8 * fq);
    f32x4 gnv[8];
#pragma unroll
    for (int t = 0; t < 8; ++t) gnv[t] = *(const f32x4*)(p.in[12] + 16 * t + 4 * fq);
    f32x4 o[8]; float ss = 0.f;
#pragma unroll
    for (int t = 0; t < 8; ++t) {
        f32x4 a = {bflo(obv[t].x), bfhi(obv[t].x), bflo(obv[t].y), bfhi(obv[t].y)};
#pragma unroll
        for (int s = 0; s < 4; ++s) a = MFMA16(sf[t][s], qf[s], a);
        o[t] = a; ss += (a[0] * a[0] + a[1] * a[1]) + (a[2] * a[2] + a[3] * a[3]); }
    ss += __shfl_xor(ss, 16); ss += __shfl_xor(ss, 32);
    const float rstd = 1.f / sqrtf(ss * (1.f / 128.f) + EPS);
    bf16* MIX = (bf16*)(ws + WS_MIX);
#pragma unroll
    for (int t = 0; t < 8; ++t) { const int e = 16 * t + 4 * fq;
        const f32x4 gn = gnv[t];
        f32x4 y; y[0] = o[t][0] * rstd * gn[0] * siluf(bflo(zv[t].x)); y[1] = o[t][1] * rstd * gn[1] * siluf(bfhi(zv[t].x)); y[2] = o[t][2] * rstd * gn[2] * siluf(bflo(zv[t].y)); y[3] = o[t][3] * rstd * gn[3] * siluf(bfhi(zv[t].y));
        *(u32x2*)(MIX + row * 1024 + 512 + h * 128 + e) = pk4(y); }
}

DI void sample_gdn_unit(const Params& p, LAS unsigned char* lds, int unit, int tid, int wid, int lane) {
    asm volatile("" : "+v"(tid), "+v"(lane));
    const int b = unit >> 2, h = unit & 3; const size_t row = MP + b;
    unsigned char* ws = p.ws;
    LAS float* qs = (LAS float*)lds; LAS float* ks = qs + 128; LAS float* vs = qs + 256; LAS float* red = qs + 384; LAS float* red2 = qs + 896; LAS float* ssw = qs + 1408;
    const bf16* QG = (const bf16*)(ws + WS_QG); const float* AB = (const float*)(ws + WS_AB);
    const int e = tid & 127, dg = tid >> 7;
    const float* S0 = p.in[5] + ((size_t)(b * 4 + h) * 128 + dg * 32) * 128 + e;
    float S[32];
#pragma unroll
    for (int i = 0; i < 32; ++i) S[i] = S0[i * 128];
    const float a_ab = AB[row * 8 + h], b_ab = AB[row * 8 + 4 + h], dtb = p.in[11][h], alog = p.in[10][h];
    const float zraw = bf2f(((const bf16*)(ws + WS_Z))[row * 512 + h * 128 + e]), gnv = p.in[12][e];
    float val = 0.f; const int prt = tid >> 7, d = tid & 127;
    if (tid < 384) { const int col = prt * 512 + h * 128 + d; const float* cw = p.in[9]; const float* sc = p.in[2] + (size_t)b * 3 * 1536 + col;
        const float y = cw[col] * sc[0] + cw[1536 + col] * sc[1536] + cw[3072 + col] * sc[3072] + cw[4608 + col] * bf2f(QG[row * 1536 + col]);
        val = siluf(y); const float s = wave_sum(val * val); if (lane == 0) ssw[wid] = s; }
    __syncthreads();
    if (tid < 384) { if (prt == 0) qs[d] = val * 0.08838834764831845f / sqrtf(ssw[0] + ssw[1] + EPS); else if (prt == 1) ks[d] = val / sqrtf(ssw[2] + ssw[3] + EPS); else vs[d] = val; }
    __syncthreads();
    const float xs = a_ab + dtb;
    const float g = -__expf(alog) * (fmaxf(xs, 0.f) + log1pf(__expf(-fabsf(xs))));
    const float beta = 1.f / (1.f + __expf(-b_ab)), eg = __expf(g);
    float kvp = 0.f;
#pragma unroll
    for (int i = 0; i < 32; ++i) { S[i] *= eg; kvp += ks[dg * 32 + i] * S[i]; }
    red[dg * 128 + e] = kvp;
    __syncthreads();
    const float u = (vs[e] - (red[e] + red[128 + e] + red[256 + e] + red[384 + e])) * beta;
    float* So = p.out + O_SSG + ((size_t)(b * 4 + h) * 128 + dg * 32) * 128 + e; float op = 0.f;
#pragma unroll
    for (int i = 0; i < 32; ++i) { S[i] += ks[dg * 32 + i] * u; op += qs[dg * 32 + i] * S[i]; So[i * 128] = S[i]; }
    red2[dg * 128 + e] = op;
    __syncthreads();
    float o = 0.f;
    if (tid < 128) { o = red2[e] + red2[128 + e] + red2[256 + e] + red2[384 + e]; const float s = wave_sum(o * o); if (lane == 0) ssw[8 + wid] = s; }
    __syncthreads();
    if (tid < 128) { const float rstd = 1.f / sqrtf((ssw[8] + ssw[9]) * (1.f / 128.f) + EPS);
        const float y = o * rstd * gnv * siluf(zraw);
        ((bf16*)(ws + WS_MIX))[row * 1024 + 512 + h * 128 + e] = (bf16)(pk2(y, 0.f) & 0xffffu); }
    __syncthreads();
}
DI void sample_attn_unit(const Params& p, LAS unsigned char* lds, int b, int tid, int wid, int lane) {
    asm volatile("" : "+v"(tid), "+v"(lane));
    unsigned char* ws = p.ws; const size_t row = MP + b;
    const bf16* QA = (const bf16*)(ws + WS_QA); const bf16* KV = (const bf16*)(ws + WS_KV);
    LAS float* Kl = (LAS float*)lds;
    LAS float* Vl = (LAS float*)(lds + 2 * 128 * 68 * 4);
    const float* kc = p.in[3] + (size_t)b * 16384; const float* vc = p.in[4] + (size_t)b * 16384;
    float* ok = p.out + O_SCK + (size_t)b * 16384; float* ov = p.out + O_SCV + (size_t)b * 16384;
    f32x4 kreg[8], vreg[8];
#pragma unroll
    for (int q = 0; q < 8; ++q) { const int i4 = tid + 512 * q; kreg[q] = *(const f32x4*)(kc + 4 * i4); vreg[q] = *(const f32x4*)(vc + 4 * i4); }
#pragma unroll
    for (int q = 0; q < 8; ++q) { const int i4 = tid + 512 * q, key = i4 >> 5, kvh = (i4 >> 4) & 1, d4 = (i4 & 15) * 4;
        *(LAS f32x4*)(Kl + (kvh * 128 + key) * 68 + d4) = kreg[q]; *(LAS f32x4*)(Vl + (kvh * 128 + key) * 68 + d4) = vreg[q];
        if (key >= 1) { *(f32x4*)(ok + 4 * i4 - 128) = kreg[q]; *(f32x4*)(ov + 4 * i4 - 128) = vreg[q]; } }
    if (tid < 32) { const u32x2 kn = *(const u32x2*)(KV + row * 256 + 4 * tid), vn = *(const u32x2*)(KV + row * 256 + 128 + 4 * tid);
        *(f32x4*)(ok + 127 * 128 + 4 * tid) = (f32x4){bflo(kn.x), bfhi(kn.x), bflo(kn.y), bfhi(kn.y)}; *(f32x4*)(ov + 127 * 128 + 4 * tid) = (f32x4){bflo(vn.x), bfhi(vn.x), bflo(vn.y), bfhi(vn.y)}; }
    __syncthreads();
    const int h = wid, kvh = h >> 2;
    const float slope = exp2f(-(float)(h + 1)), sink = p.in[8][h];
    const LAS float* Kh = Kl + kvh * 128 * 68; const LAS float* Vh = Vl + kvh * 128 * 68;
    float s0 = 0.f, s1 = 0.f, s2 = 0.f;
#pragma unroll
    for (int c4 = 0; c4 < 16; ++c4) { const u32x2 qv = *(const u32x2*)(QA + row * 512 + h * 64 + 4 * c4);
        const float q0 = bflo(qv.x), q1 = bfhi(qv.x), q2 = bflo(qv.y), q3 = bfhi(qv.y);
        const f32x4 k0 = *(const LAS f32x4*)(Kh + lane * 68 + 4 * c4), k1 = *(const LAS f32x4*)(Kh + (lane + 64) * 68 + 4 * c4);
        const u32x2 kn = *(const u32x2*)(KV + row * 256 + kvh * 64 + 4 * c4);
        s0 += q0 * k0[0] + q1 * k0[1] + q2 * k0[2] + q3 * k0[3]; s1 += q0 * k1[0] + q1 * k1[1] + q2 * k1[2] + q3 * k1[3];
        s2 += q0 * bflo(kn.x) + q1 * bfhi(kn.x) + q2 * bflo(kn.y) + q3 * bfhi(kn.y); }
    s0 = s0 * 0.125f - slope * (float)(128 - lane); s1 = s1 * 0.125f - slope * (float)(64 - lane); s2 = s2 * 0.125f;
    float mx = fmaxf(fmaxf(s0, s1), fmaxf(s2, sink));
#pragma unroll
    for (int o = 1; o < 64; o <<= 1) mx = fmaxf(mx, __shfl_xor(mx, o));
    const float p0 = __expf(s0 - mx), p1 = __expf(s1 - mx), p2 = __expf(s2 - mx);
    const float inv = 1.f / (wave_sum(p0 + p1) + p2 + __expf(sink - mx));
    float o = p2 * bf2f(KV[row * 256 + 128 + kvh * 64 + lane]);
#pragma unroll
    for (int j = 0; j < 64; ++j) { o += __int_as_float(__builtin_amdgcn_readlane(__float_as_int(p0), j)) * Vh[j * 68 + lane] + __int_as_float(__builtin_amdgcn_readlane(__float_as_int(p1), j)) * Vh[(j + 64) * 68 + lane]; }
    ((bf16*)(ws + WS_MIX))[row * 1024 + h * 64 + lane] = (bf16)(pk2(o * inv, 0.f) & 0xffffu);
    __syncthreads();
}
DI void state_copies(const Params& p, int gtid, int nthr) {
    unsigned char* ws = p.ws; const bf16* QG = (const bf16*)(ws + WS_QG); const bf16* KV = (const bf16*)(ws + WS_KV);
    for (int idx = gtid; idx < 9216; idx += nthr) { const int b = idx / 4608, i = (idx % 4608) / 1536, ch = idx % 1536; p.out[O_PSC + idx] = bf2f(QG[(size_t)(b * SEQ + SEQ - 3 + i) * 1536 + ch]); }
    for (int idx = gtid; idx < 32768; idx += nthr) { const int b = idx >> 14, j = (idx >> 7) & 127, cc = idx & 127; const size_t r = (size_t)(b * SEQ + SEQ - 128 + j) * 256;
        p.out[O_PCK + idx] = bf2f(KV[r + cc]); p.out[O_PCV + idx] = bf2f(KV[r + 128 + cc]); }
    for (int idx = gtid; idx < 589824; idx += nthr) { const int b = idx / 4608, i = (idx % 4608) / 1536, ch = idx % 1536;
        p.out[O_SSC + idx] = i < 2 ? p.in[2][(size_t)(b * 3 + i + 1) * 1536 + ch] : bf2f(QG[(size_t)(MP + b) * 1536 + ch]); }
}

DI void norm_rows_mid(const Params& p, int gw, int NGW, int lane) {
    asm volatile("" : "+v"(lane));
    unsigned char* ws = p.ws; const bf16* T1 = (const bf16*)(ws + WS_T1); bf16* XN = (bf16*)(ws + WS_XN); bf16* X1B = (bf16*)(ws + WS_MIX);
    f32x4 g1[4], g2[4];
#pragma unroll
    for (int j = 0; j < 4; ++j) { g1[j] = *(const f32x4*)(p.in[14] + 4 * lane + 256 * j); g2[j] = *(const f32x4*)(p.in[15] + 4 * lane + 256 * j); }
    f32x4 nt[4], nxx[4];
    { const int m0 = gw < MR ? gw : 0; const float* xr0 = m0 < MP ? p.in[0] + (size_t)m0 * D : p.in[1] + (size_t)(m0 - MP) * D;
#pragma unroll
      for (int j = 0; j < 4; ++j) { { const u32x2 tb = *(const u32x2*)(T1 + (size_t)m0 * D + 4 * lane + 256 * j); nt[j] = (f32x4){bflo(tb.x), bfhi(tb.x), bflo(tb.y), bfhi(tb.y)}; } nxx[j] = *(const f32x4*)(xr0 + 4 * lane + 256 * j); } }
    for (int m = gw; m < MR; m += NGW) {
        f32x4 t[4], x[4]; float s = 0.f;
#pragma unroll
        for (int j = 0; j < 4; ++j) { t[j] = nt[j]; x[j] = nxx[j]; s += (t[j][0] * t[j][0] + t[j][1] * t[j][1]) + (t[j][2] * t[j][2] + t[j][3] * t[j][3]); }
        { const int mn = (m + NGW < MR) ? m + NGW : m; const float* xrn = mn < MP ? p.in[0] + (size_t)mn * D : p.in[1] + (size_t)(mn - MP) * D;
#pragma unroll
          for (int j = 0; j < 4; ++j) { { const u32x2 tb = *(const u32x2*)(T1 + (size_t)mn * D + 4 * lane + 256 * j); nt[j] = (f32x4){bflo(tb.x), bfhi(tb.x), bflo(tb.y), bfhi(tb.y)}; } nxx[j] = *(const f32x4*)(xrn + 4 * lane + 256 * j); } }
        const float rstd = 1.f / sqrtf(wave_sum(s) * (1.f / D) + EPS); float s2 = 0.f;
#pragma unroll
        for (int j = 0; j < 4; ++j) { x[j] = x[j] + t[j] * rstd * g1[j]; *(u32x2*)(X1B + (size_t)m * D + 4 * lane + 256 * j) = pk4(x[j]); s2 += (x[j][0] * x[j][0] + x[j][1] * x[j][1]) + (x[j][2] * x[j][2] + x[j][3] * x[j][3]); }
        const float rstd2 = 1.f / sqrtf(wave_sum(s2) * (1.f / D) + EPS);
#pragma unroll
        for (int j = 0; j < 4; ++j) *(u32x2*)(XN + (size_t)m * D + 4 * lane + 256 * j) = pk4(x[j] * rstd2 * g2[j]);
    }
}
DI void norm_rows_fin(const Params& p, int gw, int NGW, int lane) {
    asm volatile("" : "+v"(lane));
    const bf16* T2 = (const bf16*)(p.ws + WS_T2); const bf16* X1B = (const bf16*)(p.ws + WS_MIX);
    f32x4 g1[4];
#pragma unroll
    for (int j = 0; j < 4; ++j) g1[j] = *(const f32x4*)(p.in[18] + 4 * lane + 256 * j);
    f32x4 nt[4], nxx[4];
    { const int m0 = gw < MR ? gw : 0;
#pragma unroll
      for (int j = 0; j < 4; ++j) { { const u32x2 tb = *(const u32x2*)(T2 + (size_t)m0 * D + 4 * lane + 256 * j); nt[j] = (f32x4){bflo(tb.x), bfhi(tb.x), bflo(tb.y), bfhi(tb.y)}; } { const u32x2 xb = *(const u32x2*)(X1B + (size_t)m0 * D + 4 * lane + 256 * j); nxx[j] = (f32x4){bflo(xb.x), bfhi(xb.x), bflo(xb.y), bfhi(xb.y)}; } } }
    for (int m = gw; m < MR; m += NGW) {
        f32x4 t[4], x[4]; float s = 0.f;
#pragma unroll
        for (int j = 0; j < 4; ++j) { t[j] = nt[j]; x[j] = nxx[j]; s += (t[j][0] * t[j][0] + t[j][1] * t[j][1]) + (t[j][2] * t[j][2] + t[j][3] * t[j][3]); }
        { const int mn = (m + NGW < MR) ? m + NGW : m;
#pragma unroll
          for (int j = 0; j < 4; ++j) { { const u32x2 tb = *(const u32x2*)(T2 + (size_t)mn * D + 4 * lane + 256 * j); nt[j] = (f32x4){bflo(tb.x), bfhi(tb.x), bflo(tb.y), bfhi(tb.y)}; } { const u32x2 xb = *(const u32x2*)(X1B + (size_t)mn * D + 4 * lane + 256 * j); nxx[j] = (f32x4){bflo(xb.x), bfhi(xb.x), bflo(xb.y), bfhi(xb.y)}; } } }
        const float rstd = 1.f / sqrtf(wave_sum(s) * (1.f / D) + EPS);
#pragma unroll
        for (int j = 0; j < 4; ++j) *(f32x4*)(p.out + (size_t)m * D + 4 * lane + 256 * j) = x[j] + t[j] * rstd * g1[j];
    }
}

#define XB_TMO      128
#define XB_XCNT(j)  (256  + 64 * (j))
#define XB_XSUB(j)  (1280 + 64 * (j))
#define XB_XGEN(j)  (2304 + 64 * (j))
#define XB_TOP      3328
#define XB_TOPGEN   3392
#define XCD_BAR_WORDS 3456
#define XB_SPIN_CAP (1u << 18)

__device__ __forceinline__ unsigned xb_ld(unsigned* p)              { return __hip_atomic_load(p, __ATOMIC_RELAXED, __HIP_MEMORY_SCOPE_AGENT); }
__device__ __forceinline__ unsigned xb_add(unsigned* p, unsigned v) { return __hip_atomic_fetch_add(p, v, __ATOMIC_RELAXED, __HIP_MEMORY_SCOPE_AGENT); }
__device__ __forceinline__ unsigned xb_xcc_id() { return (unsigned)__builtin_amdgcn_s_getreg((3 << 11) | 20) & 0xFu; }
#define XB_SPIN(cond, bar) do { unsigned _sp = 0; while (cond) { __builtin_amdgcn_s_sleep(1); \
    if ((++_sp & 255u) == 0u) { if (xb_ld(&(bar)[XB_TMO])) break; if (_sp > XB_SPIN_CAP) { atomicAdd(&(bar)[XB_TMO], 1u); break; } } } } while (0)

struct XcdBarrier {
    unsigned* bar; unsigned x;
    volatile LAS unsigned* st;
};

__device__ __forceinline__ XcdBarrier xcd_barrier_post(unsigned* bar, volatile LAS unsigned* st) {
    XcdBarrier b; b.bar = bar; b.x = xb_xcc_id(); b.st = st;
    if (threadIdx.x == 0) (void)xb_add(&bar[XB_XCNT(b.x)], 1u);
    return b;
}
__device__ __forceinline__ void xcd_barrier_complete(unsigned* bar, unsigned x, unsigned& nloc, unsigned& nx) {
    const unsigned G = gridDim.x * gridDim.y * gridDim.z;
    unsigned sum, cnt, mine, sp = 0u;
    for (;;) {
        sum = 0u; cnt = 0u; mine = 0u;
#pragma unroll
        for (unsigned j = 0; j < 16; ++j) { const unsigned c = xb_ld(&bar[XB_XCNT(j)]); sum += c; cnt += (c > 0u) ? 1u : 0u; mine = (j == x) ? c : mine; }
        if (sum == G) break;
        __builtin_amdgcn_s_sleep(1);
        if ((++sp & 255u) == 0u) { if (xb_ld(&bar[XB_TMO])) break; if (sp > XB_SPIN_CAP) { atomicAdd(&bar[XB_TMO], 1u); break; } }
    }
    nloc = mine > 0u ? mine : 1u; nx = cnt > 0u ? cnt : 1u;
}

__device__ __forceinline__ void xcd_barrier(const XcdBarrier& b) {
    asm volatile("s_waitcnt vmcnt(0)" ::: "memory");
    __syncthreads();
    if (threadIdx.x == 0) {
        unsigned* bar = b.bar;
        __builtin_amdgcn_s_waitcnt(0);
        unsigned nloc = b.st[0], nx = b.st[1];
        if (nloc == 0u) { xcd_barrier_complete(bar, b.x, nloc, nx); b.st[0] = nloc; b.st[1] = nx; }
        const unsigned old = xb_add(&bar[XB_XSUB(b.x)], 1u);
        const unsigned gen = old / nloc;
        if (old + 1u == (gen + 1u) * nloc) {
            __builtin_amdgcn_fence(__ATOMIC_RELEASE, "agent");
            asm volatile("s_waitcnt vmcnt(0)" ::: "memory");
            const unsigned og = xb_add(&bar[XB_TOP], 1u);
            const unsigned tg = og / nx;
            if (og + 1u == (tg + 1u) * nx) xb_add(&bar[XB_TOPGEN], 1u);
            else XB_SPIN(xb_ld(&bar[XB_TOPGEN]) == tg, bar);
            __builtin_amdgcn_fence(__ATOMIC_ACQUIRE, "agent");
            xb_add(&bar[XB_XGEN(b.x)], 1u);
            asm volatile("s_waitcnt vmcnt(0)" ::: "memory");
        } else {
            XB_SPIN(xb_ld(&bar[XB_XGEN(b.x)]) == gen, bar);
            __builtin_amdgcn_fence(__ATOMIC_ACQUIRE, "agent");
            asm volatile("s_waitcnt vmcnt(0)" ::: "memory");
        }
    }
    __syncthreads();
}

struct StoreF32 { float* O; int ldc; DI void operator()(int r, int c, float v) const { O[(size_t)r * ldc + c] = v; } };
struct StoreBf16 { bf16* O; int ldc; DI void operator()(int r, int c, float v) const { O[(size_t)r * ldc + c] = (bf16)(pk2(v, 0.f) & 0xffffu); } };
struct StoreRelu2 { bf16* O; int ldc; DI void operator()(int r, int c, float v) const { const float a = fmaxf(v, 0.f); O[(size_t)r * ldc + c] = (bf16)(pk2(a * a, 0.f) & 0xffffu); } };
template <int TMT, int TNT, class Store>
DI void small_gemm_tile(const bf16* A, const bf16* Bt, int K, int row0, int col0, LAS float* part, int tid, int wid, int lane, const Store& st) {
    asm volatile("" : "+v"(tid), "+v"(lane));
    const int fr = lane & 15, fq = lane >> 4, ks = K >> 3;
    f32x4 acc[TMT][TNT];
#pragma unroll
    for (int m = 0; m < TMT; ++m)
#pragma unroll
        for (int n = 0; n < TNT; ++n) acc[m][n] = (f32x4){0.f, 0.f, 0.f, 0.f};
    const bf16* ap = A + (size_t)(row0 + fr) * K + wid * ks + 8 * fq;
    const bf16* bp = Bt + (size_t)(col0 + fr) * K + wid * ks + 8 * fq;
#pragma unroll 4
    for (int k = 0; k < ks; k += 32) {
        bf16x8 a[TMT], b[TNT];
#pragma unroll
        for (int m = 0; m < TMT; ++m) a[m] = *(const bf16x8*)(ap + (size_t)m * 16 * K + k);
#pragma unroll
        for (int n = 0; n < TNT; ++n) b[n] = *(const bf16x8*)(bp + (size_t)n * 16 * K + k);
#pragma unroll
        for (int m = 0; m < TMT; ++m)
#pragma unroll
            for (int n = 0; n < TNT; ++n) acc[m][n] = MFMA16(a[m], b[n], acc[m][n]);
    }
    constexpr int TM = TMT * 16, TN = TNT * 16;
#pragma unroll
    for (int m = 0; m < TMT; ++m)
#pragma unroll
        for (int n = 0; n < TNT; ++n)
#pragma unroll
            for (int i = 0; i < 4; ++i) part[(wid * TM + m * 16 + 4 * fq + i) * TN + n * 16 + fr] = acc[m][n][i];
    __syncthreads();
    for (int idx = tid; idx < TM * TN; idx += 512) { const int r = idx / TN, c = idx % TN; float v = 0.f;
#pragma unroll
        for (int w = 0; w < 8; ++w) v += part[(w * TM + r) * TN + c];
        st(row0 + r, col0 + c, v); }
    __syncthreads();
}

__global__ void __launch_bounds__(512, 2) fwd_megakernel(Params p) {
    extern __shared__ __attribute__((aligned(16))) unsigned char lds_raw[];
    LAS unsigned char* lds = (LAS unsigned char*)lds_raw;
    cg::grid_group grid = cg::this_grid();
    const int wid = __builtin_amdgcn_readfirstlane(threadIdx.x >> 6);
#define FRESH int tid = threadIdx.x; asm volatile("" : "+v"(tid)); int lane = tid & 63; (void)lane
    const int G = gridDim.x, bx = blockIdx.x;
    if (threadIdx.x < 16) ((LAS unsigned*)(lds + LDS_CTL))[threadIdx.x] = 0u;
    __syncthreads();
    XcdBarrier xbar = xcd_barrier_post((unsigned*)(p.ws + WS_BAR), (volatile LAS unsigned*)(lds + LDS_CTL));
#define GSYNC() do { if (p.use_cg) grid.sync(); else xcd_barrier(xbar); } while (0)
    const int gw = bx * 8 + wid, NGW = G * 8;
    unsigned char* ws = p.ws;
#ifndef PHM
#define PHM 0xFFFF
#endif
    { FRESH; if (PHM & 1) p0_prologue(p, lds, gw, NGW, wid, lane); }
    GSYNC();
    if (PHM & 2) { pg8::Gemm g{(const pg8::bf16_t*)(ws + WS_XN), (const pg8::bf16_t*)(ws + WS_WIN), MPAD, NIN, D}; pg8::StaticOrder S; S.init(MPAD, NIN, G, bx);
      pg8::EpiInProj E{(pg8::bf16_t*)(ws + WS_QA), (pg8::bf16_t*)(ws + WS_KV), (pg8::bf16_t*)(ws + WS_QG), (pg8::bf16_t*)(ws + WS_Z)};
      pg8::gemm_phase<pg8::EpiInProj, pg8::StaticOrder, true, true>(lds, g, S, E); }
    { FRESH; const int nfull = (MPAD / 256) * (NIN / 256) % G;
      if (nfull != 0 && bx >= nfull) late_transposes(p, lds, (bx - nfull) * 8 + wid, (G - nfull) * 8, wid, lane);
      else if (nfull == 0) late_transposes(p, lds, gw, NGW, wid, lane); }
    GSYNC();
    { FRESH; if ((G & 7) == 0) { const int per = G >> 3;
          for (int n = bx >> 3; n < 64; n += per) { if (PHM & 4) gdn_prep_unit(p, lds, (bx & 7) * 128 + n, tid, wid, lane); } }
      else for (int u = bx; u < 512; u += G) { if (PHM & 4) gdn_prep_unit(p, lds, (u >> 6) * 128 + (u & 63), tid, wid, lane); } }
    { FRESH; state_copies(p, bx * 512 + tid, G * 512); }
    GSYNC();
    { FRESH; if (bx < 64) { if (PHM & 32) scan_phase<0>(p, lds, bx, wid, lane); }
    else if ((G & 7) == 0) { const int per = (G - 64) >> 3;
        for (int n = (bx - 64) >> 3; n < 64; n += per) { if (PHM & 4) gdn_prep_unit(p, lds, (bx & 7) * 128 + 64 + n, tid, wid, lane); } }
    else for (int u = bx - 64; u < 512; u += G - 64) { if (PHM & 4) gdn_prep_unit(p, lds, (u >> 6) * 128 + 64 + (u & 63), tid, wid, lane); } }
    GSYNC();
    { FRESH; if (bx < 64) { if (PHM & 32) scan_phase<1>(p, lds, bx, wid, lane); }
    else if (G == 256) {
        const int w = bx - 64;
        if (PHM & 64) attn_unit(p, lds, w, tid, wid, lane);
        if (w < 64) { if (PHM & 64) attn_unit(p, lds, w + 192, tid, wid, lane);
            if (PHM & 8) { sample_gdn_unit(p, lds, 2 * w, tid, wid, lane); sample_gdn_unit(p, lds, 2 * w + 1, tid, wid, lane); } }
        else { if (PHM & 16) sample_attn_unit(p, lds, w - 64, tid, wid, lane);
            if (PHM & 8) { for (int q = 0; q < 3; ++q) sample_gdn_unit(p, lds, 128 + 3 * (w - 64) + q, tid, wid, lane); } } }
    else for (int u = bx - 64; u < 896; u += G - 64) {
        if (u < 256) { if (PHM & 64) attn_unit(p, lds, u, tid, wid, lane); }
        else if (u < 768) { if (PHM & 8) sample_gdn_unit(p, lds, u - 256, tid, wid, lane); }
        else { if (PHM & 16) sample_attn_unit(p, lds, u - 768, tid, wid, lane); } } }
    GSYNC();
    { FRESH; if ((G & 7) == 0) { const int per = G >> 3;
          for (int j = bx >> 3; j < 64; j += per) { if (PHM & 128) gdn_out_pair(p, (bx & 7) * 64 + j, wid, lane); } }
      else for (int u = bx; u < 512; u += G) { if (PHM & 128) gdn_out_pair(p, u, wid, lane); } }
    GSYNC();
    if (PHM & 256) { pg8::Gemm g{(const pg8::bf16_t*)(ws + WS_MIX), (const pg8::bf16_t*)(ws + WS_WOUT), MP, D, D}; pg8::StaticOrder S; S.init(MP, D, G, bx);
      pg8::EpiBf16p E{(pg8::bf16_t*)(ws + WS_T1), D};
      pg8::gemm_phase<pg8::EpiBf16p, pg8::StaticOrder, true, true>(lds, g, S, E); }
    { FRESH; for (int t = bx; t < 256; t += G) small_gemm_tile<1, 2>((const bf16*)(ws + WS_MIX), (const bf16*)(ws + WS_WOUT), D, MP + (t >> 5) * 16, (t & 31) * 32, (LAS float*)lds, tid, wid, lane, StoreBf16{(bf16*)(ws + WS_T1), D}); }
    GSYNC();
    { FRESH; if (PHM & 512) norm_rows_mid(p, gw, NGW, lane); }
    GSYNC();
    if (PHM & 1024) { pg8::Gemm g{(const pg8::bf16_t*)(ws + WS_XN), (const pg8::bf16_t*)(ws + WS_WUP), MP, FF, D}; pg8::StaticOrder S; S.init(MP, FF, G, bx);
      pg8::EpiRelu2 E{(pg8::bf16_t*)(ws + WS_H), FF};
      pg8::gemm_phase<pg8::EpiRelu2, pg8::StaticOrder, true, true>(lds, g, S, E); }
    { FRESH; for (int t = bx; t < 256; t += G) small_gemm_tile<2, 4>((const bf16*)(ws + WS_XN), (const bf16*)(ws + WS_WUP), D, MP + (t >> 6) * 32, (t & 63) * 64, (LAS float*)lds, tid, wid, lane, StoreRelu2{(bf16*)(ws + WS_H), FF}); }
    GSYNC();
    if (PHM & 2048) { pg8::Gemm g{(const pg8::bf16_t*)(ws + WS_H), (const pg8::bf16_t*)(ws + WS_WDN), MP, D, FF}; pg8::StaticOrder S; S.init(MP, D, G, bx);
      pg8::EpiBf16p E{(pg8::bf16_t*)(ws + WS_T2), D};
      pg8::gemm_phase<pg8::EpiBf16p, pg8::StaticOrder, true, true>(lds, g, S, E); }
    { FRESH; for (int t = bx; t < 256; t += G) small_gemm_tile<1, 2>((const bf16*)(ws + WS_H), (const bf16*)(ws + WS_WDN), FF, MP + (t >> 5) * 16, (t & 31) * 32, (LAS float*)lds, tid, wid, lane, StoreBf16{(bf16*)(ws + WS_T2), D}); }
    GSYNC();
    { FRESH; if (PHM & 4096) norm_rows_fin(p, gw, NGW, lane); }
}

extern "C" void kernel_launch(void* const* d_in, const int* in_sizes, int n_in, void* d_out, int out_size, void* d_ws, size_t ws_size, hipStream_t stream) {
    static int grid = 0;
    if (grid == 0) {
        if (n_in != 19 || ws_size < WS_END) { fprintf(stderr, "kernel_launch: unexpected n_in %d / ws_size %zu\n", n_in, ws_size); grid = -1; return; }
        int dev = 0, cus = 0, per_cu = 0;
        hipGetDevice(&dev); hipDeviceGetAttribute(&cus, hipDeviceAttributeMultiprocessorCount, dev);
        if (hipFuncSetAttribute((const void*)fwd_megakernel, hipFuncAttributeMaxDynamicSharedMemorySize, LDS_BYTES) != hipSuccess) { fprintf(stderr, "kernel_launch: hipFuncSetAttribute failed\n"); }
        hipOccupancyMaxActiveBlocksPerMultiprocessor(&per_cu, (const void*)fwd_megakernel, 512, LDS_BYTES);
        (void)hipGetLastError();
        if (per_cu < 1) { fprintf(stderr, "kernel_launch: occupancy query says %d blocks/CU\n", per_cu); per_cu = 1; }
        grid = cus;
        if (grid < 65) { fprintf(stderr, "kernel_launch: grid %d too small\n", grid); grid = -1; return; }
    }
    if (grid < 0) return;
    Params p{};
    for (int i = 0; i < 19; ++i) p.in[i] = (const float*)d_in[i];
    p.out = (float*)d_out; p.ws = (unsigned char*)d_ws; p.use_cg = 0; p.pad = 0;
    (void)hipMemsetAsync((unsigned char*)d_ws + WS_BAR, 0, 16384, stream);
    void* args[] = {&p};
    hipError_t e = hipLaunchCooperativeKernel((const void*)fwd_megakernel, dim3(grid), dim3(512), args, LDS_BYTES, stream);
    if (e != hipSuccess) fprintf(stderr, "cooperative launch failed: %s (grid %d)\n", hipGetErrorString(e), grid);
}
```

```cpp
#include <hip/hip_runtime.h>
#include <hip/hip_cooperative_groups.h>
#include <cstdio>
#include <cstdint>
namespace cg = cooperative_groups;
namespace pg8 {
#define PG8_LAS __attribute__((address_space(3)))
typedef unsigned short bf16_t;
typedef short bf16x8 __attribute__((ext_vector_type(8)));
typedef float f32x4 __attribute__((ext_vector_type(4)));
typedef unsigned u32x4 __attribute__((ext_vector_type(4)));
constexpr int BM = 256, BK = 64, HALF = 128, HTB = HALF * BK * 2  , STAGE_BYTES = 8 * HTB, NXCD = 8, WGM = 2;

__host__ __device__ __forceinline__ int lds_byte(int r, int c) { const int st = (r >> 4) * 2 + (c >> 5), rr = r & 15, cc = c & 31, ob = rr * 64 + cc * 2; return st * 1024 + (ob ^ (((ob >> 9) & 1) << 5)); }
__host__ __device__ __forceinline__ void stage_rc(int b, int& R, int& C) { const int st = b / 1024, sb = b % 1024, swz = sb ^ (((sb >> 9) & 1) << 5); R = (st >> 1) * 16 + swz / 64; C = (st & 1) * 32 + (swz % 64) / 2; }
__host__ __device__ __forceinline__ int perm32(int rho) { const int n = rho >> 4, i = rho & 15; return 8 * (i >> 2) + 4 * n + (i & 3); }

struct Unit { int pm, pn; };
struct Gemm { const bf16_t* A; const bf16_t* Bt; int M, N, K; };

struct StaticOrder {
    int nM, nN, nwg, G, c;
    __host__ __device__ void init(int M, int N, int G_, int c_) { nM = M / BM; nN = N / BM; nwg = nM * nN; G = G_; c = c_; }
    __host__ __device__ bool next(int i, Unit& u) const {
        const long L = (long)i * G + c; if (L >= nwg) return false;
        int wgid = (int)L; { const int q = nwg / NXCD, r = nwg % NXCD, xcd = wgid % NXCD, off = wgid / NXCD; wgid = (xcd < r ? xcd * (q + 1) : r * (q + 1) + (xcd - r) * q) + off; }
        const int nig = WGM * nN, gid = wgid / nig, fm = gid * WGM, gsz = (nM - fm) < WGM ? (nM - fm) : WGM;
        u.pm = fm + ((wgid % nig) % gsz); u.pn = (wgid % nig) / gsz; return true;
    }
    __device__ __forceinline__ void a_ready(const Unit&) const {}
    __device__ __forceinline__ void done(const Unit&) const {}
};

typedef unsigned u32x2e __attribute__((ext_vector_type(2)));
typedef __bf16 bf2e_t __attribute__((ext_vector_type(2)));
typedef float f32x2e __attribute__((ext_vector_type(2)));
__device__ __forceinline__ unsigned cvt_pk_bf16(float lo, float hi) { f32x2e v = {lo, hi}; return __builtin_bit_cast(unsigned, __builtin_convertvector(v, bf2e_t)); }
struct EpiInProj {
    static constexpr bool PERM = true, AFTER_DRAIN = false;
    bf16_t *QA, *KV, *QG, *Z;
    __device__ __forceinline__ void operator()(const f32x4 (&acc)[2][2][4][2], const Unit& u, int wr, int wc, int fr, int fq) const {
        const int pn = u.pn; bf16_t* base; int ldc, colt;
        if (pn < 2) { base = QA; ldc = 512; colt = pn * 256; } else if (pn == 2) { base = KV; ldc = 256; colt = 0; } else if (pn < 9) { base = QG; ldc = 1536; colt = (pn - 3) * 256; } else { base = Z; ldc = 512; colt = (pn - 9) * 256; }
        const int row0 = u.pm * BM + wr * 64 + fr, col0 = colt + wc * 32 + 8 * fq;
#pragma unroll
        for (int ai = 0; ai < 2; ++ai)
#pragma unroll
            for (int m = 0; m < 4; ++m) { bf16_t* rowp = base + (size_t)(row0 + ai * HALF + m * 16) * ldc + col0;
#pragma unroll
                for (int bj = 0; bj < 2; ++bj) { const f32x4 v0 = acc[ai][bj][m][0], v1 = acc[ai][bj][m][1];
                    u32x4 w; w.x = cvt_pk_bf16(v0[0], v0[1]); w.y = cvt_pk_bf16(v0[2], v0[3]); w.z = cvt_pk_bf16(v1[0], v1[1]); w.w = cvt_pk_bf16(v1[2], v1[3]);
                    *(u32x4*)(rowp + bj * HALF) = w; } }
    }
};
struct EpiRelu2 {
    static constexpr bool PERM = true, AFTER_DRAIN = false;
    bf16_t* O; int ldc;
    __device__ __forceinline__ void operator()(const f32x4 (&acc)[2][2][4][2], const Unit& u, int wr, int wc, int fr, int fq) const {
        const int row0 = u.pm * BM + wr * 64 + fr, col0 = u.pn * BM + wc * 32 + 8 * fq;
#pragma unroll
        for (int ai = 0; ai < 2; ++ai)
#pragma unroll
            for (int m = 0; m < 4; ++m) { bf16_t* rowp = O + (size_t)(row0 + ai * HALF + m * 16) * ldc + col0;
#pragma unroll
                for (int bj = 0; bj < 2; ++bj) { f32x4 v0 = acc[ai][bj][m][0], v1 = acc[ai][bj][m][1];
#pragma unroll
                    for (int e = 0; e < 4; ++e) { const float a = fmaxf(v0[e], 0.f), b = fmaxf(v1[e], 0.f); v0[e] = a * a; v1[e] = b * b; }
                    u32x4 w; w.x = cvt_pk_bf16(v0[0], v0[1]); w.y = cvt_pk_bf16(v0[2], v0[3]); w.z = cvt_pk_bf16(v1[0], v1[1]); w.w = cvt_pk_bf16(v1[2], v1[3]);
                    *(u32x4*)(rowp + bj * HALF) = w; } }
    }
};
struct EpiBf16p {
    static constexpr bool PERM = true, AFTER_DRAIN = false;
    bf16_t* O; int ldc;
    __device__ __forceinline__ void operator()(const f32x4 (&acc)[2][2][4][2], const Unit& u, int wr, int wc, int fr, int fq) const {
        const int row0 = u.pm * BM + wr * 64 + fr, col0 = u.pn * BM + wc * 32 + 8 * fq;
#pragma unroll
        for (int ai = 0; ai < 2; ++ai)
#pragma unroll
            for (int m = 0; m < 4; ++m) { bf16_t* rowp = O + (size_t)(row0 + ai * HALF + m * 16) * ldc + col0;
#pragma unroll
                for (int bj = 0; bj < 2; ++bj) { f32x4 v0 = acc[ai][bj][m][0], v1 = acc[ai][bj][m][1];
                    u32x4 w; w.x = cvt_pk_bf16(v0[0], v0[1]); w.y = cvt_pk_bf16(v0[2], v0[3]); w.z = cvt_pk_bf16(v1[0], v1[1]); w.w = cvt_pk_bf16(v1[2], v1[3]);
                    *(u32x4*)(rowp + bj * HALF) = w; } }
    }
};
struct EpiF32 {
    static constexpr bool PERM = true, AFTER_DRAIN = false;
    float* O; int ldc;
    __device__ __forceinline__ void operator()(const f32x4 (&acc)[2][2][4][2], const Unit& u, int wr, int wc, int fr, int fq) const {
        const int row0 = u.pm * BM + wr * 64 + fr, col0 = u.pn * BM + wc * 32 + 8 * fq;
#pragma unroll
        for (int ai = 0; ai < 2; ++ai)
#pragma unroll
            for (int m = 0; m < 4; ++m) { float* rowp = O + (size_t)(row0 + ai * HALF + m * 16) * ldc + col0;
#pragma unroll
                for (int bj = 0; bj < 2; ++bj) { *(f32x4*)(rowp + bj * HALF) = acc[ai][bj][m][0]; *(f32x4*)(rowp + bj * HALF + 4) = acc[ai][bj][m][1]; } }
    }
};
template <class Epi, class Sched, bool ALIGN_EPI = false, bool SP2 = false>
__device__ __forceinline__ void gemm_phase(PG8_LAS unsigned char* lds, const Gemm g, const Sched& S, const Epi& E) {
    int tid_ = threadIdx.x; asm volatile("" : "+v"(tid_));
    const int tid = tid_, wid = __builtin_amdgcn_readfirstlane(tid >> 6), lane = tid & 63, wr = wid >> 2, wc = wid & 3, fr = lane & 15, fq = lane >> 4;
    const int K = g.K, nt = K / BK;
    unsigned voffA[2], voffB[2];
#pragma unroll
    for (int i = 0; i < 2; ++i) { int R, C; stage_rc(tid * 16 + i * 8192, R, C); const int Rb = Epi::PERM ? ((R & ~31) + perm32(R & 31)) : R;
        voffA[i] = (unsigned)(R * K + C) * 2u; voffB[i] = (unsigned)(Rb * K + C) * 2u; }
    const size_t kstep = (size_t)(BK * 2);
    const size_t hstep = (size_t)HALF * K * 2;
    const size_t tstep = 2 * hstep;
    const unsigned ldsw = (unsigned)wid * 1024u;
    const int aoff = lds_byte(wr * 64 + fr, fq * 8), boff = lds_byte(wc * 32 + fr, fq * 8);
#define PG8_SA(b, h) (((b) * 2 + (h)) * HTB)
#define PG8_SB(b, h) ((4 + (b) * 2 + (h)) * HTB)
#define PG8_STAGE(bufoff, gbase, voff) do { _Pragma("unroll") for (int _i = 0; _i < 2; ++_i) \
        __builtin_amdgcn_global_load_lds((const unsigned*)((const char*)(gbase) + (voff)[_i]), (PG8_LAS unsigned*)(lds + (bufoff) + ldsw + _i * 8192), 16, 0, 0); } while (0)
#define PG8_LDA(dst, b, h) do { _Pragma("unroll") for (int m = 0; m < 4; ++m) _Pragma("unroll") for (int k = 0; k < 2; ++k) dst[m][k] = *(const PG8_LAS bf16x8*)(lds + PG8_SA(b, h) + aoff + m * 2048 + k * 1024); } while (0)
#define PG8_LDB(dst, b, h) do { _Pragma("unroll") for (int n = 0; n < 2; ++n) _Pragma("unroll") for (int k = 0; k < 2; ++k) dst[n][k] = *(const PG8_LAS bf16x8*)(lds + PG8_SB(b, h) + boff + n * 2048 + k * 1024); } while (0)
#define PG8_MMA(ai, bj, At, Bt) do { __builtin_amdgcn_s_setprio(1); _Pragma("unroll") for (int m = 0; m < 4; ++m) _Pragma("unroll") for (int n = 0; n < 2; ++n) _Pragma("unroll") for (int k = 0; k < 2; ++k) \
        acc[ai][bj][m][n] = __builtin_amdgcn_mfma_f32_16x16x32_bf16(Bt[n][k], At[m][k], acc[ai][bj][m][n], 0, 0, 0); __builtin_amdgcn_s_setprio(0); } while (0)
#define PG8_WAIT_V(n) asm volatile("s_waitcnt vmcnt(" #n ")" ::: "memory")
#define PG8_WAIT_L(n) asm volatile("s_waitcnt lgkmcnt(" #n ")" ::: "memory")
#define PG8_BAR __builtin_amdgcn_s_barrier()
#define PG8_SCHED __builtin_amdgcn_sched_barrier(0)
    Unit cur, nxt; int ui = 0;
    if (!S.next(0, cur)) return;
    f32x4 acc[2][2][4][2];
#pragma unroll
    for (int a = 0; a < 2; ++a)
#pragma unroll
        for (int b = 0; b < 2; ++b)
#pragma unroll
            for (int m = 0; m < 4; ++m)
#pragma unroll
                for (int n = 0; n < 2; ++n) acc[a][b][m][n] = (f32x4){0.f, 0.f, 0.f, 0.f};
    bf16x8 At[4][2], B0[2][2], B1[2][2];
    const char* cA = (const char*)g.A + (size_t)cur.pm * tstep; const char* cB = (const char*)g.Bt + (size_t)cur.pn * tstep;
    S.a_ready(cur);
    if constexpr (SP2) {
        PG8_STAGE(PG8_SB(0, 0), cB, voffB); PG8_STAGE(PG8_SB(0, 1), cB + hstep, voffB); PG8_STAGE(PG8_SA(0, 0), cA, voffA); PG8_STAGE(PG8_SA(0, 1), cA + hstep, voffA);
        if (wr == 1) PG8_BAR;
        PG8_WAIT_V(2); PG8_BAR;
        PG8_STAGE(PG8_SB(1, 0), cB + kstep, voffB); PG8_STAGE(PG8_SA(1, 0), cA + kstep, voffA); PG8_STAGE(PG8_SB(1, 1), cB + hstep + kstep, voffB);
        PG8_WAIT_V(6); PG8_BAR;
    } else {
        PG8_STAGE(PG8_SB(0, 0), cB, voffB); PG8_STAGE(PG8_SA(0, 0), cA, voffA); PG8_STAGE(PG8_SB(0, 1), cB + hstep, voffB); PG8_STAGE(PG8_SA(0, 1), cA + hstep, voffA);
        if (wr == 1) PG8_BAR;
        PG8_WAIT_V(4); PG8_BAR;
        PG8_STAGE(PG8_SB(1, 0), cB + kstep, voffB); PG8_STAGE(PG8_SA(1, 0), cA + kstep, voffA); PG8_STAGE(PG8_SB(1, 1), cB + hstep + kstep, voffB);
        PG8_WAIT_V(6); PG8_BAR;
    }
    for (;;) {
        const bool has_next = S.next(ui + 1, nxt);
        const char* nA = has_next ? (const char*)g.A + (size_t)nxt.pm * tstep : cA; const char* nB = has_next ? (const char*)g.Bt + (size_t)nxt.pn * tstep : cB;
        for (int t = 0; t < nt; t += 2) {
            const bool last = (t == nt - 2);
            const char* a1 = cA + (size_t)(t + 1) * kstep;
            const char* a2 = last ? nA : cA + (size_t)(t + 2) * kstep; const char* b2 = last ? nB : cB + (size_t)(t + 2) * kstep;
            const char* a3 = a2 + kstep; const char* b3 = b2 + kstep;
            if (last && has_next) S.a_ready(nxt);
            if constexpr (SP2) {
            PG8_LDB(B0, 0, 0); PG8_LDB(B1, 0, 1); PG8_SCHED; PG8_LDA(At, 0, 0); PG8_STAGE(PG8_SA(1, 1), a1 + hstep, voffA);
            PG8_WAIT_V(8); PG8_WAIT_L(0); PG8_BAR; PG8_MMA(0, 0, At, B0); PG8_MMA(0, 1, At, B1); PG8_BAR; PG8_SCHED;
            PG8_LDA(At, 0, 1); PG8_STAGE(PG8_SB(0, 0), b2, voffB); PG8_STAGE(PG8_SB(0, 1), b2 + hstep, voffB); PG8_STAGE(PG8_SA(0, 0), a2, voffA);
            PG8_WAIT_V(8); PG8_WAIT_L(0); PG8_BAR; PG8_MMA(1, 0, At, B0); PG8_MMA(1, 1, At, B1); PG8_BAR; PG8_SCHED;
            PG8_LDB(B0, 1, 0); PG8_LDB(B1, 1, 1); PG8_SCHED; PG8_LDA(At, 1, 0); PG8_STAGE(PG8_SA(0, 1), a2 + hstep, voffA);
            PG8_WAIT_V(8); PG8_WAIT_L(0); PG8_BAR; PG8_MMA(0, 0, At, B0); PG8_MMA(0, 1, At, B1); PG8_BAR; PG8_SCHED;
            PG8_LDA(At, 1, 1); PG8_STAGE(PG8_SB(1, 0), b3, voffB); PG8_STAGE(PG8_SB(1, 1), b3 + hstep, voffB); PG8_STAGE(PG8_SA(1, 0), a3, voffA);
            PG8_WAIT_V(8); PG8_WAIT_L(0); PG8_BAR; PG8_MMA(1, 0, At, B0); PG8_MMA(1, 1, At, B1); PG8_BAR; PG8_SCHED;
            } else {
            PG8_LDB(B0, 0, 0); PG8_SCHED; PG8_LDA(At, 0, 0); PG8_STAGE(PG8_SA(1, 1), a1 + hstep, voffA);
            PG8_WAIT_L(8); PG8_BAR; PG8_WAIT_L(0); PG8_MMA(0, 0, At, B0); PG8_BAR; PG8_SCHED;
            PG8_LDB(B1, 0, 1); PG8_STAGE(PG8_SB(0, 0), b2, voffB);
            PG8_BAR; PG8_WAIT_L(0); PG8_MMA(0, 1, At, B1); PG8_BAR;
            PG8_LDA(At, 0, 1); PG8_STAGE(PG8_SA(0, 0), a2, voffA);
            PG8_BAR; PG8_WAIT_L(0); PG8_MMA(1, 0, At, B0); PG8_BAR; PG8_SCHED;
            PG8_STAGE(PG8_SB(0, 1), b2 + hstep, voffB);
            PG8_WAIT_V(6); PG8_BAR; PG8_MMA(1, 1, At, B1); PG8_BAR;
            PG8_LDB(B0, 1, 0); PG8_SCHED; PG8_LDA(At, 1, 0); PG8_STAGE(PG8_SA(0, 1), a2 + hstep, voffA);
            PG8_WAIT_L(8); PG8_BAR; PG8_WAIT_L(0); PG8_MMA(0, 0, At, B0); PG8_BAR; PG8_SCHED;
            PG8_LDB(B1, 1, 1); PG8_STAGE(PG8_SB(1, 0), b3, voffB);
            PG8_BAR; PG8_WAIT_L(0); PG8_MMA(0, 1, At, B1); PG8_BAR;
            PG8_LDA(At, 1, 1); PG8_STAGE(PG8_SA(1, 0), a3, voffA);
            PG8_BAR; PG8_WAIT_L(0); PG8_MMA(1, 0, At, B0); PG8_BAR; PG8_SCHED;
            PG8_STAGE(PG8_SB(1, 1), b3 + hstep, voffB);
            PG8_WAIT_V(6); PG8_BAR; PG8_MMA(1, 1, At, B1); PG8_BAR;
            }
        }
        if constexpr (ALIGN_EPI) { if (wr == 0) PG8_BAR; }
        if constexpr (!Epi::AFTER_DRAIN) { E(acc, cur, wr, wc, fr, fq); S.done(cur); }
        if (!has_next) break;
#pragma unroll
        for (int a = 0; a < 2; ++a)
#pragma unroll
            for (int b = 0; b < 2; ++b)
#pragma unroll
                for (int m = 0; m < 4; ++m)
#pragma unroll
                    for (int n = 0; n < 2; ++n) acc[a][b][m][n] = (f32x4){0.f, 0.f, 0.f, 0.f};
        cur = nxt; cA = nA; cB = nB; ++ui;
        if constexpr (ALIGN_EPI) { if (wr == 1) PG8_BAR; }
    }
    PG8_WAIT_V(0);
    if constexpr (!ALIGN_EPI) { if (wr == 0) PG8_BAR; }
    PG8_BAR;
    if constexpr (Epi::AFTER_DRAIN) { E.fused(acc, cur, wr, wc, fr, fq, lds, wid, lane); S.done(cur); }
#undef PG8_SA
#undef PG8_SB
#undef PG8_STAGE
#undef PG8_LDA
#undef PG8_LDB
#undef PG8_MMA
#undef PG8_WAIT_V
#undef PG8_WAIT_L
#undef PG8_BAR
#undef PG8_SCHED
}
}
#define LAS __attribute__((address_space(3)))
#define DI __device__ __forceinline__
typedef unsigned short bf16;
typedef short bf16x8 __attribute__((ext_vector_type(8)));
typedef float f32x4 __attribute__((ext_vector_type(4)));
typedef float f32x2 __attribute__((ext_vector_type(2)));
typedef unsigned u32x4 __attribute__((ext_vector_type(4)));
typedef unsigned u32x2 __attribute__((ext_vector_type(2)));
typedef __bf16 bf2_t __attribute__((ext_vector_type(2)));
#define MFMA16(a, b, c) __builtin_amdgcn_mfma_f32_16x16x32_bf16((a), (b), (c), 0, 0, 0)
DI unsigned pk2(float lo, float hi) { f32x2 v = {lo, hi}; return __builtin_bit_cast(unsigned, __builtin_convertvector(v, bf2_t)); }
DI u32x2 pk4(f32x4 v) { u32x2 r; r.x = pk2(v[0], v[1]); r.y = pk2(v[2], v[3]); return r; }
DI float bf2f(bf16 h) { return __uint_as_float((unsigned)h << 16); }
DI float bflo(unsigned u) { return __uint_as_float(u << 16); }
DI float bfhi(unsigned u) { return __uint_as_float(u & 0xffff0000u); }
DI float wave_sum(float v) {
#pragma unroll
    for (int o = 1; o < 64; o <<= 1) v += __shfl_xor(v, o);
    return v;
}
DI float siluf(float y) { return y / (1.f + __expf(-y)); }

constexpr int D = 1024, SEQ = 8192, MP = 16384, MS = 128, MR = MP + MS, MPAD = 16640, NIN = 2816, INW = 2824, FF = 4096;
constexpr float EPS = 1e-6f;
constexpr size_t MiB = 1u << 20;
constexpr size_t WS_LD = 0, WS_AB = 65536;
constexpr size_t WS_WIN = 1 * MiB, WS_WOUT = 7 * MiB, WS_WUP = 9 * MiB, WS_WDN = 17 * MiB;
constexpr size_t WS_XN = 25 * MiB, WS_QT = 25 * MiB, WS_OB = 41 * MiB, WS_MIX = 58 * MiB;
constexpr size_t WS_QA = 91 * MiB, WS_KV = 107 * MiB + 512 * 1024, WS_QG = 116 * MiB, WS_SG = 116 * MiB, WS_Z = 165 * MiB, WS_MP = 182 * MiB, WS_BST = 214 * MiB;
constexpr size_t WS_T1 = 91 * MiB, WS_H = 91 * MiB, WS_T2 = 25 * MiB, WS_END = 256 * MiB;
constexpr size_t O_Y = 0, O_PSC = 16908288, O_PCK = 16917504, O_PCV = 16950272, O_PSG = 16983040, O_SSC = 17114112, O_SCK = 17703936, O_SCV = 19801088, O_SSG = 21898240;
constexpr int LDS_CTL = 147456, LDS_XB = 147456 + 64, LDS_BYTES = 147456 + 64 + 8192;
constexpr size_t WS_BAR = 32768;

struct Params { const float* in[19]; float* out; unsigned char* ws; int use_cg, pad; };

DI void p0_transpose_item(const float* W, int ldw, int N, int K, bf16* WT, LAS float* scr, int item, int lane) {
    const int nblk = N / 32, kb = item / nblk, nb = item % nblk, k0 = 64 * kb, n0 = 32 * nb;
#pragma unroll 8
    for (int i = 0; i < 32; ++i) { const int kk = 2 * i + (lane >> 5); scr[kk * 33 + (lane & 31)] = W[(size_t)(k0 + kk) * ldw + n0 + (lane & 31)]; }
    asm volatile("s_waitcnt lgkmcnt(0)" ::: "memory");
    const int c = lane & 7;
#pragma unroll
    for (int j = 0; j < 4; ++j) { const int n = (lane >> 3) + 8 * j; const LAS float* s = scr + (8 * c) * 33 + n;
        u32x4 o; o.x = pk2(s[0 * 33], s[1 * 33]); o.y = pk2(s[2 * 33], s[3 * 33]); o.z = pk2(s[4 * 33], s[5 * 33]); o.w = pk2(s[6 * 33], s[7 * 33]);
        *(u32x4*)(WT + (size_t)(n0 + n) * K + k0 + 8 * c) = o; }
    asm volatile("s_waitcnt lgkmcnt(0)" ::: "memory");
}
DI void p0_prologue(const Params& p, LAS unsigned char* lds, int gw, int NGW, int wid, int lane) {
    asm volatile("" : "+v"(lane));
    LAS float* scr = (LAS float*)(lds + wid * 16384);
    unsigned char* ws = p.ws;
    constexpr int I_IN = (D / 64) * (NIN / 32);
    for (int it = gw; it < I_IN; it += NGW) p0_transpose_item(p.in[7], INW, NIN, D, (bf16*)(ws + WS_WIN), scr, it, lane);
    f32x4 wab[4][4][2];
    const float* win = p.in[7];
#pragma unroll
    for (int j = 0; j < 4; ++j)
#pragma unroll
        for (int e = 0; e < 4; ++e) { const float* wp = win + (size_t)(4 * lane + 256 * j + e) * INW + NIN; wab[j][e][0] = *(const f32x4*)wp; wab[j][e][1] = *(const f32x4*)(wp + 4); }
    f32x4 gv[4];
#pragma unroll
    for (int j = 0; j < 4; ++j) gv[j] = *(const f32x4*)(p.in[6] + 4 * lane + 256 * j);
    bf16* XN = (bf16*)(ws + WS_XN); float* AB = (float*)(ws + WS_AB);
    f32x4 nx[4];
    { const int m0 = gw < MR ? gw : 0; const float* xr0 = m0 < MP ? p.in[0] + (size_t)m0 * D : p.in[1] + (size_t)(m0 - MP) * D;
#pragma unroll
      for (int j = 0; j < 4; ++j) nx[j] = *(const f32x4*)(xr0 + 4 * lane + 256 * j); }
    for (int m = gw; m < MR; m += NGW) {
        f32x4 v[4]; float s = 0.f;
#pragma unroll
        for (int j = 0; j < 4; ++j) { v[j] = nx[j]; s += (v[j][0] * v[j][0] + v[j][1] * v[j][1]) + (v[j][2] * v[j][2] + v[j][3] * v[j][3]); }
        { const int mn = (m + NGW < MR) ? m + NGW : m; const float* xrn = mn < MP ? p.in[0] + (size_t)mn * D : p.in[1] + (size_t)(mn - MP) * D;
#pragma unroll
          for (int j = 0; j < 4; ++j) nx[j] = *(const f32x4*)(xrn + 4 * lane + 256 * j); }
        const float rstd = 1.f / sqrtf(wave_sum(s) * (1.f / D) + EPS);
        f32x4 a0 = {0.f, 0.f, 0.f, 0.f}, a1 = {0.f, 0.f, 0.f, 0.f};
#pragma unroll
        for (int j = 0; j < 4; ++j) { v[j] = v[j] * rstd * gv[j];
#pragma unroll
            for (int e = 0; e < 4; ++e) { a0 += wab[j][e][0] * v[j][e]; a1 += wab[j][e][1] * v[j][e]; }
            *(u32x2*)(XN + (size_t)m * D + 4 * lane + 256 * j) = pk4(v[j]); }
#pragma unroll
        for (int e = 0; e < 4; ++e) { a0[e] = wave_sum(a0[e]); a1[e] = wave_sum(a1[e]); }
        if (lane == 0) { *(f32x4*)(AB + (size_t)m * 8) = a0; *(f32x4*)(AB + (size_t)m * 8 + 4) = a1; }
    }
}

DI void late_transposes(const Params& p, LAS unsigned char* lds, int gw, int NGW, int wid, int lane) {
    asm volatile("" : "+v"(lane));
    LAS float* scr = (LAS float*)(lds + wid * 16384);
    unsigned char* ws = p.ws;
    constexpr int I_O = (D / 64) * (D / 32), I_U = (D / 64) * (FF / 32), I_D = (FF / 64) * (D / 32);
    for (int it = gw; it < I_O + I_U + I_D; it += NGW) {
        int r = it;
        if (r < I_O) { p0_transpose_item(p.in[13], D, D, D, (bf16*)(ws + WS_WOUT), scr, r, lane); continue; } r -= I_O;
        if (r < I_U) { p0_transpose_item(p.in[16], FF, FF, D, (bf16*)(ws + WS_WUP), scr, r, lane); continue; } r -= I_U;
        p0_transpose_item(p.in[17], D, D, FF, (bf16*)(ws + WS_WDN), scr, r, lane);
    }
}

DI bf16x8 ldfrag(const LAS bf16* base, int pitch, int r0, int k0, int fr, int fq) { return *(const LAS bf16x8*)(base + (r0 + fr) * pitch + k0 + 8 * fq); }

DI void gdn_prep_unit(const Params& p, LAS unsigned char* lds, int unit, int tid, int wid, int lane) {
    asm volatile("" : "+v"(tid), "+v"(lane));
    const int c = unit >> 7, n = unit & 127, b = c >> 2, h = c & 3;
    const int rowbase = b * SEQ + n * 64;
    const int fr = lane & 15, fq = lane >> 4;
    unsigned char* ws = p.ws;
    LAS bf16* q_rm = (LAS bf16*)(lds);
    LAS bf16* k_rm = (LAS bf16*)(lds + 17408);
    LAS float* Amat = (LAS float*)(lds + 34816);
    LAS bf16* UT = (LAS bf16*)(lds + 17408);
    LAS bf16* XT = (LAS bf16*)(lds + 54272);
    LAS bf16* kdT = (LAS bf16*)(lds + 91136);
    LAS bf16* Tinv = (LAS bf16*)(lds + 109568);
    LAS bf16* qk = (LAS bf16*)(lds + 118784);
    LAS float* sG = (LAS float*)(lds + 128000);
    LAS float* sBeta = sG + 64; LAS float* sEG = sG + 128; LAS float* sEKD = sG + 192; LAS float* sRS = sG + 256;
    LAS float* part = Amat;
    LAS bf16* T11T = (LAS bf16*)(lds + 130048); LAS bf16* A21b = (LAS bf16*)(lds + 132608); LAS bf16* PT = (LAS bf16*)(lds + 135168);
    const bf16* QG = (const bf16*)(ws + WS_QG);
    const float* AB = (const float*)(ws + WS_AB);
    if (wid == 7) {
        const float a = AB[(size_t)(rowbase + lane) * 8 + h], bb = AB[(size_t)(rowbase + lane) * 8 + 4 + h];
        const float xs = a + p.in[11][h];
        const float sp = fmaxf(xs, 0.f) + log1pf(__expf(-fabsf(xs)));
        const float g = -__expf(p.in[10][h]) * sp;
        float G = g;
#pragma unroll
        for (int o = 1; o < 64; o <<= 1) { const float t = __int_as_float(__builtin_amdgcn_ds_bpermute(((lane - o) & 63) << 2, __float_as_int(G))); if (lane >= o) G += t; }
        const float Gl = __int_as_float(__builtin_amdgcn_readlane(__float_as_int(G), 63));
        sG[lane] = G; sBeta[lane] = 1.f / (1.f + __expf(-bb)); sEG[lane] = __expf(G); sEKD[lane] = __expf(Gl - G);
        if (lane == 63) ((float*)(ws + WS_LD))[unit] = __expf(G);
    }
    float val[8][8];
    const int cgp = tid >> 3, tr = tid & 7, prt = cgp >> 4, d0 = (cgp & 15) * 8, t0 = tr * 8;
    if (tid < 384) {
        const int col = prt * 512 + h * 128 + d0;
        float w[4][8];
#pragma unroll
        for (int i = 0; i < 4; ++i) { const f32x4 w0 = *(const f32x4*)(p.in[9] + i * 1536 + col), w1 = *(const f32x4*)(p.in[9] + i * 1536 + col + 4);
#pragma unroll
            for (int e = 0; e < 4; ++e) { w[i][e] = w0[e]; w[i][4 + e] = w1[e]; } }
#pragma unroll
        for (int tt = 0; tt < 8; ++tt)
#pragma unroll
            for (int e = 0; e < 8; ++e) val[tt][e] = 0.f;
#pragma unroll
        for (int r = 0; r < 11; ++r) {
            const int tl = n * 64 + t0 + r - 3;
            u32x4 xv = {0u, 0u, 0u, 0u};
            if (tl >= 0) xv = *(const u32x4*)(QG + (size_t)(b * SEQ + tl) * 1536 + col);
            float x[8] = {bflo(xv.x), bfhi(xv.x), bflo(xv.y), bfhi(xv.y), bflo(xv.z), bfhi(xv.z), bflo(xv.w), bfhi(xv.w)};
#pragma unroll
            for (int i = 0; i < 4; ++i) { const int tt = r - i;
                if (tt >= 0 && tt < 8) {
#pragma unroll
                    for (int e = 0; e < 8; ++e) val[tt][e] += w[i][e] * x[e]; } }
        }
#pragma unroll
        for (int tt = 0; tt < 8; ++tt) { float s = 0.f;
#pragma unroll
            for (int e = 0; e < 8; ++e) { val[tt][e] = siluf(val[tt][e]); s += val[tt][e] * val[tt][e]; }
            if (prt < 2) part[(prt * 64 + t0 + tt) * 16 + (cgp & 15)] = s; }
    }
    __syncthreads();
    if (tid < 128) { float s = 0.f;
#pragma unroll
        for (int i = 0; i < 16; ++i) s += part[tid * 16 + ((i + tid) & 15)];
        sRS[tid] = (tid < 64 ? 0.08838834764831845f : 1.f) / sqrtf(s + EPS); }
    __syncthreads();
    if (tid < 384) {
        if (prt == 0) {
#pragma unroll
            for (int tt = 0; tt < 8; ++tt) { const float r = sRS[t0 + tt]; u32x4 o; o.x = pk2(val[tt][0] * r, val[tt][1] * r); o.y = pk2(val[tt][2] * r, val[tt][3] * r); o.z = pk2(val[tt][4] * r, val[tt][5] * r); o.w = pk2(val[tt][6] * r, val[tt][7] * r);
                *(LAS u32x4*)(q_rm + (t0 + tt) * 136 + d0) = o; }
        } else if (prt == 1) {
            float be[8], kd[8];
#pragma unroll
            for (int tt = 0; tt < 8; ++tt) { const float r = sRS[64 + t0 + tt]; be[tt] = sBeta[t0 + tt] * sEG[t0 + tt]; kd[tt] = sEKD[t0 + tt];
#pragma unroll
                for (int e = 0; e < 8; ++e) val[tt][e] *= r;
                u32x4 o; o.x = pk2(val[tt][0], val[tt][1]); o.y = pk2(val[tt][2], val[tt][3]); o.z = pk2(val[tt][4], val[tt][5]); o.w = pk2(val[tt][6], val[tt][7]);
                *(LAS u32x4*)(k_rm + (t0 + tt) * 136 + d0) = o; }
#pragma unroll
            for (int e = 0; e < 8; ++e) { u32x4 o, o2;
                o.x = pk2(val[0][e] * be[0], val[1][e] * be[1]); o.y = pk2(val[2][e] * be[2], val[3][e] * be[3]); o.z = pk2(val[4][e] * be[4], val[5][e] * be[5]); o.w = pk2(val[6][e] * be[6], val[7][e] * be[7]);
                o2.x = pk2(val[0][e] * kd[0], val[1][e] * kd[1]); o2.y = pk2(val[2][e] * kd[2], val[3][e] * kd[3]); o2.z = pk2(val[4][e] * kd[4], val[5][e] * kd[5]); o2.w = pk2(val[6][e] * kd[6], val[7][e] * kd[7]);
                *(LAS u32x4*)(XT + (128 + d0 + e) * 72 + t0) = o; *(LAS u32x4*)(kdT + (d0 + e) * 72 + t0) = o2; }
        } else {
            float be[8];
#pragma unroll
            for (int tt = 0; tt < 8; ++tt) be[tt] = sBeta[t0 + tt];
#pragma unroll
            for (int e = 0; e < 8; ++e) { u32x4 o;
                o.x = pk2(val[0][e] * be[0], val[1][e] * be[1]); o.y = pk2(val[2][e] * be[2], val[3][e] * be[3]); o.z = pk2(val[4][e] * be[4], val[5][e] * be[5]); o.w = pk2(val[6][e] * be[6], val[7][e] * be[7]);
                *(LAS u32x4*)(XT + (d0 + e) * 72 + t0) = o; }
        }
    }
    __syncthreads();
#pragma unroll
    for (int q = 0; q < 2; ++q) { const int idx = wid + 8 * q, it = idx >> 2, jt = idx & 3;
        if (jt <= it) { f32x4 acc = {0.f, 0.f, 0.f, 0.f};
#pragma unroll
            for (int s = 0; s < 4; ++s) acc = MFMA16(ldfrag(k_rm, 136, it * 16, 32 * s, fr, fq), ldfrag(k_rm, 136, jt * 16, 32 * s, fr, fq), acc);
            const int j = jt * 16 + fr; const float Gj = sG[j];
#pragma unroll
            for (int i2 = 0; i2 < 4; ++i2) { const int i = it * 16 + 4 * fq + i2; const float av = sBeta[i] * acc[i2] * __expf(fminf(sG[i] - Gj, 0.f)); Amat[i * 68 + j] = av;
                if (it >= 2 && jt < 2) A21b[(i - 32) * 40 + j] = (bf16)(pk2(av, 0.f) & 0xffffu); } } }
    __syncthreads();
    if (wid < 2) {
#ifndef NOINV
        const int o = 32 * wid, cl = lane & 31;
        float T[32];
#pragma unroll
        for (int i = 0; i < 32; ++i) { float a = (i == cl) ? 1.f : 0.f;
#pragma unroll
            for (int jg = 0; jg < (i + 3) / 4; ++jg) { const f32x4 av = *(const LAS f32x4*)(Amat + (o + i) * 68 + o + 4 * jg);
#pragma unroll
                for (int e = 0; e < 4; ++e) if (4 * jg + e < i) a -= av[e] * T[4 * jg + e]; }
            T[i] = a; }
        if (lane < 32) {
#pragma unroll
            for (int i = 0; i < 32; i += 2) { const unsigned pk = pk2(T[i], T[i + 1]); Tinv[(o + i) * 72 + o + cl] = (bf16)(pk & 0xffffu); Tinv[(o + i + 1) * 72 + o + cl] = (bf16)(pk >> 16); }
            if (wid == 0) {
#pragma unroll
                for (int i = 0; i < 32; i += 8) { u32x4 w; w.x = pk2(T[i], T[i + 1]); w.y = pk2(T[i + 2], T[i + 3]); w.z = pk2(T[i + 4], T[i + 5]); w.w = pk2(T[i + 6], T[i + 7]); *(LAS u32x4*)(T11T + cl * 40 + i) = w; } }
        } else if (wid == 0) {
#pragma unroll
            for (int i = 0; i < 32; ++i) Tinv[i * 72 + 32 + cl] = 0;
        }
#endif
    } else {
        for (int idx = wid - 2; idx < 16; idx += 6) { const int it = idx >> 2, jt = idx & 3;
            f32x4 acc = {0.f, 0.f, 0.f, 0.f};
            if (jt <= it) {
#pragma unroll
                for (int s = 0; s < 4; ++s) acc = MFMA16(ldfrag(k_rm, 136, jt * 16, 32 * s, fr, fq), ldfrag(q_rm, 136, it * 16, 32 * s, fr, fq), acc);
                const int i = it * 16 + fr; const float Gi = sG[i];
#pragma unroll
                for (int i2 = 0; i2 < 4; ++i2) { const int j = jt * 16 + 4 * fq + i2; acc[i2] = (i >= j) ? acc[i2] * __expf(fminf(Gi - sG[j], 0.f)) : 0.f; } }
            *(LAS u32x2*)(qk + (it * 16 + fr) * 72 + jt * 16 + 4 * fq) = pk4(acc); }
    }
    __syncthreads();
    if (wid == 0) {
#pragma unroll
        for (int jt = 0; jt < 2; ++jt) { const bf16x8 yv = *(const LAS bf16x8*)(T11T + (jt * 16 + fr) * 40 + 8 * fq);
#pragma unroll
            for (int it = 0; it < 2; ++it) { f32x4 a = {0.f, 0.f, 0.f, 0.f}; a = MFMA16(*(const LAS bf16x8*)(A21b + (it * 16 + fr) * 40 + 8 * fq), yv, a);
                *(LAS u32x2*)(PT + (jt * 16 + fr) * 40 + it * 16 + 4 * fq) = pk4(a); } }
        asm volatile("s_waitcnt lgkmcnt(0)" ::: "memory");
#pragma unroll
        for (int jt = 0; jt < 2; ++jt) { const bf16x8 yv = *(const LAS bf16x8*)(PT + (jt * 16 + fr) * 40 + 8 * fq);
#pragma unroll
            for (int it = 0; it < 2; ++it) { f32x4 a = {0.f, 0.f, 0.f, 0.f}; a = MFMA16(*(const LAS bf16x8*)(Tinv + (32 + it * 16 + fr) * 72 + 32 + 8 * fq), yv, a);
                const u32x2 w = pk4(-a); const int j = jt * 16 + fr, i0 = 32 + it * 16 + 4 * fq;
                Tinv[i0 * 72 + j] = (bf16)(w.x & 0xffffu); Tinv[(i0 + 1) * 72 + j] = (bf16)(w.x >> 16); Tinv[(i0 + 2) * 72 + j] = (bf16)(w.y & 0xffffu); Tinv[(i0 + 3) * 72 + j] = (bf16)(w.y >> 16); } }
    }
    __syncthreads();
    { int t2 = threadIdx.x; asm volatile("" : "+v"(t2)); lane = t2 & 63; }
    const int fr3 = lane & 15, fq3 = lane >> 4;
#pragma unroll
    for (int q = 0; q < 2; ++q) { const int ft = 2 * wid + q;
        const bf16x8 y0 = ldfrag(XT, 72, ft * 16, 0, fr3, fq3), y1 = ldfrag(XT, 72, ft * 16, 32, fr3, fq3);
        f32x4 acc[4];
#pragma unroll
        for (int ct = 0; ct < 4; ++ct) { acc[ct] = (f32x4){0.f, 0.f, 0.f, 0.f}; acc[ct] = MFMA16(ldfrag(Tinv, 72, ct * 16, 0, fr3, fq3), y0, acc[ct]); acc[ct] = MFMA16(ldfrag(Tinv, 72, ct * 16, 32, fr3, fq3), y1, acc[ct]); }
#pragma unroll
        for (int ct = 0; ct < 4; ++ct) *(LAS u32x2*)(UT + (ft * 16 + fr3) * 72 + ct * 16 + 4 * fq3) = pk4(acc[ct]); }
    __syncthreads();
    {
        bf16* MPo = (bf16*)(ws + WS_MP) + (size_t)unit * 16384;
        bf16* BSo = (bf16*)(ws + WS_BST) + (size_t)unit * 16384;
        bf16* QTo = (bf16*)(ws + WS_QT) + (size_t)unit * 8192;
        bf16* OBo = (bf16*)(ws + WS_OB) + (size_t)unit * 8192;
        const bf16x8 w0 = ldfrag(UT, 72, 128 + wid * 16, 0, fr3, fq3), w1 = ldfrag(UT, 72, 128 + wid * 16, 32, fr3, fq3);
        const bf16x8 kd0 = ldfrag(kdT, 72, wid * 16, 0, fr3, fq3), kd1 = ldfrag(kdT, 72, wid * 16, 32, fr3, fq3);
        const bf16x8 u0 = ldfrag(UT, 72, wid * 16, 0, fr3, fq3), u1 = ldfrag(UT, 72, wid * 16, 32, fr3, fq3);
#pragma unroll
        for (int dt = 0; dt < 8; ++dt) {
            f32x4 a = {0.f, 0.f, 0.f, 0.f};
            a = MFMA16(w0, ldfrag(kdT, 72, dt * 16, 0, fr3, fq3), a); a = MFMA16(w1, ldfrag(kdT, 72, dt * 16, 32, fr3, fq3), a);
            const int s = wid >> 1, jb = (wid & 1) * 4, blk = dt * 4 + s;
            *(u32x2*)(MPo + ((size_t)(blk * 64 + lane) * 8 + jb)) = pk4(-a);
            f32x4 bacc = {0.f, 0.f, 0.f, 0.f};
            bacc = MFMA16(kd0, ldfrag(UT, 72, dt * 16, 0, fr3, fq3), bacc); bacc = MFMA16(kd1, ldfrag(UT, 72, dt * 16, 32, fr3, fq3), bacc);
            *(u32x2*)(BSo + ((size_t)((dt * 8 + wid) * 64 + lane) * 4)) = pk4(bacc);
        }
#pragma unroll
        for (int ct = 0; ct < 4; ++ct) {
            const bf16x8 y0 = ldfrag(qk, 72, ct * 16, 0, fr3, fq3), y1 = ldfrag(qk, 72, ct * 16, 32, fr3, fq3);
            f32x4 a = {0.f, 0.f, 0.f, 0.f}; a = MFMA16(w0, y0, a); a = MFMA16(w1, y1, a);
            const int cc = ct * 16 + fr3, dd = wid * 16 + 4 * fq3; const float eg = sEG[cc];
            const u32x2 qv = *(const LAS u32x2*)(q_rm + cc * 136 + dd);
            f32x4 o; o[0] = bflo(qv.x) * eg - a[0]; o[1] = bfhi(qv.x) * eg - a[1]; o[2] = bflo(qv.y) * eg - a[2]; o[3] = bfhi(qv.y) * eg - a[3];
            *(u32x2*)(QTo + cc * 128 + dd) = pk4(o);
            f32x4 ob = {0.f, 0.f, 0.f, 0.f}; ob = MFMA16(u0, y0, ob); ob = MFMA16(u1, y1, ob);
            *(u32x2*)(OBo + cc * 128 + dd) = pk4(ob);
        }
    }
    __syncthreads();
}
DI void scan_issue(const char* MPc, const char* BSc, LAS unsigned char* lds, int n, int lw, int lane) {
    const int slot = n & 3;
#pragma unroll
    for (int q = 0; q < 9; ++q) { const int blk = lw * 9 + q;
        const char* src = blk < 32 ? MPc + (size_t)n * 32768 + blk * 1024 : BSc + (size_t)n * 32768 + (blk - 32) * 1024;
        __builtin_amdgcn_global_load_lds((const unsigned*)(src + lane * 16), (LAS unsigned*)(lds + slot * 36864 + blk * 1024), 16, 0, 0); }
}
constexpr int PFD = 64;
template <int PART> DI void scan_phase(const Params& p, LAS unsigned char* lds, int wg, int wid, int lane) {
    constexpr int N0 = PART * 64, N1 = N0 + 64;
    asm volatile("" : "+v"(lane));
    const int c = wg & 7, sl = wg >> 3, fr = lane & 15, fq = lane >> 4, e0 = sl * 16;
    unsigned char* ws = p.ws;
    const char* MPc = (const char*)(ws + WS_MP) + (size_t)c * 128 * 32768;
    const char* BSc = (const char*)(ws + WS_BST) + (size_t)c * 128 * 32768 + sl * 4096;
    bf16* SGc = (bf16*)p.out + (size_t)c * 128 * 16384;
    const float* LD = (const float*)(ws + WS_LD) + c * 128;
    const bool loader = (wid >= 1 && wid <= 4); const int lw = wid - 1;
    unsigned pfdummy = 0u;
    f32x4 acc[8];
#pragma unroll
    for (int t = 0; t < 8; ++t) acc[t] = (f32x4){0.f, 0.f, 0.f, 0.f};
    float ldv0 = 0.f;
    if (wid == 0) { ldv0 = LD[N0 + lane];
        if (PART == 1) {
#pragma unroll
            for (int t = 0; t < 8; ++t) acc[t] = *(const LAS f32x4*)(lds + LDS_XB + (t * 64 + lane) * 16); } }
    if (loader) { scan_issue(MPc, BSc, lds, N0, lw, lane); scan_issue(MPc, BSc, lds, N0 + 1, lw, lane); scan_issue(MPc, BSc, lds, N0 + 2, lw, lane); asm volatile("s_waitcnt vmcnt(18)" ::: "memory"); }
    __builtin_amdgcn_s_barrier(); asm volatile("" ::: "memory");
    for (int n = N0; n < N1; ++n) {
        if (loader) { if (n + 3 < N1) { scan_issue(MPc, BSc, lds, n + 3, lw, lane); asm volatile("s_waitcnt vmcnt(18)" ::: "memory"); } else { asm volatile("s_waitcnt vmcnt(0)" ::: "memory"); } }
        if (wid == 5 && n + PFD < N1) {
            const char* pm = MPc + (size_t)(n + PFD) * 32768 + lane * 128; const char* pb = BSc + (size_t)(n + PFD) * 32768 + (lane & 31) * 128;
            asm volatile("global_load_dword %0, %1, off\n\tglobal_load_dword %0, %2, off\n\tglobal_load_dword %0, %3, off\n\tglobal_load_dword %0, %4, off\n\tglobal_load_dword %0, %5, off" : "+v"(pfdummy) : "v"(pm), "v"(pm + 8192), "v"(pm + 16384), "v"(pm + 24576), "v"(pb) : "memory");
        }
        if (wid == 0) {
            const LAS unsigned char* slot = lds + (n & 3) * 36864;
            bf16x8 mf[8][4];
#pragma unroll
            for (int m = 0; m < 4; ++m)
#pragma unroll
                for (int s = 0; s < 4; ++s) mf[m][s] = *(const LAS bf16x8*)(slot + (m * 4 + s) * 1024 + lane * 16);
            __builtin_amdgcn_sched_barrier(0);
            const float ld = __int_as_float(__builtin_amdgcn_readlane(__float_as_int(ldv0), n & 63));
            u32x2 pk[8];
#pragma unroll
            for (int t = 0; t < 8; ++t) { pk[t] = pk4(acc[t]); *(u32x2*)(SGc + (size_t)n * 16384 + (e0 + fr) * 128 + 16 * t + 4 * fq) = pk[t]; }
            bf16x8 Sb[4];
#pragma unroll
            for (int s = 0; s < 4; ++s) { u32x4 v; v.x = pk[2 * s].x; v.y = pk[2 * s].y; v.z = pk[2 * s + 1].x; v.w = pk[2 * s + 1].y; Sb[s] = __builtin_bit_cast(bf16x8, v); }
#pragma unroll
            for (int t = 0; t < 8; ++t) { const u32x2 bb = *(const LAS u32x2*)(slot + 32768 + t * 512 + lane * 8);
                acc[t][0] = ld * acc[t][0] + bflo(bb.x); acc[t][1] = ld * acc[t][1] + bfhi(bb.x); acc[t][2] = ld * acc[t][2] + bflo(bb.y); acc[t][3] = ld * acc[t][3] + bfhi(bb.y); }
            __builtin_amdgcn_sched_barrier(0);
#pragma unroll
            for (int m = 4; m < 8; ++m)
#pragma unroll
                for (int s = 0; s < 4; ++s) mf[m][s] = *(const LAS bf16x8*)(slot + (m * 4 + s) * 1024 + lane * 16);
            __builtin_amdgcn_sched_barrier(0);
#pragma unroll
            for (int s = 0; s < 4; ++s)
#pragma unroll
                for (int m = 0; m < 4; ++m) acc[m] = MFMA16(mf[m][s], Sb[s], acc[m]);
            __builtin_amdgcn_sched_barrier(0);
#pragma unroll
            for (int s = 0; s < 4; ++s)
#pragma unroll
                for (int m = 4; m < 8; ++m) acc[m] = MFMA16(mf[m][s], Sb[s], acc[m]);
            asm volatile("s_waitcnt lgkmcnt(0)" ::: "memory");
        }
        __builtin_amdgcn_s_barrier(); asm volatile("" ::: "memory");
    }
    if (wid == 0 && PART == 0) {
#pragma unroll
        for (int t = 0; t < 8; ++t) *(LAS f32x4*)(lds + LDS_XB + (t * 64 + lane) * 16) = acc[t]; }
    if (wid == 0 && PART == 1) { float* So = p.out + O_PSG + (size_t)c * 16384;
#pragma unroll
        for (int t = 0; t < 8; ++t)
#pragma unroll
            for (int i = 0; i < 4; ++i) So[(16 * t + 4 * fq + i) * 128 + e0 + fr] = acc[t][i]; }
    asm volatile("s_waitcnt vmcnt(0)" : "+v"(pfdummy) :: "memory");
    __syncthreads();
}

DI void attn_unit(const Params& p, LAS unsigned char* lds, int unit, int tid, int wid, int lane) {
    asm volatile("" : "+v"(tid), "+v"(lane));
    const int kvh = unit & 1, nb = (unit >> 1) & 63, b = unit >> 7;
    const int fr = lane & 15, fq = lane >> 4;
    unsigned char* ws = p.ws;
    const bf16* QA = (const bf16*)(ws + WS_QA); const bf16* KV = (const bf16*)(ws + WS_KV); bf16* MIX = (bf16*)(ws + WS_MIX);
    LAS bf16* Ks = (LAS bf16*)lds;
    LAS bf16* Vt = (LAS bf16*)(lds + 36864);
    const int tok0 = b * SEQ + 128 * (nb - 1);
    for (int it = tid; it < 2048; it += 512) { const int key = it >> 3, ch = it & 7;
        u32x4 kv = {0u, 0u, 0u, 0u}, vv = {0u, 0u, 0u, 0u};
        if (nb > 0 || key >= 128) { const bf16* src = KV + (size_t)(tok0 + key) * 256 + kvh * 64 + ch * 8; kv = *(const u32x4*)src; vv = *(const u32x4*)(src + 128); }
        *(LAS u32x4*)(Ks + key * 72 + ch * 8) = kv;
        LAS bf16* vd = Vt + (ch * 8) * 280 + key;
        vd[0] = (bf16)(vv.x & 0xffffu); vd[280] = (bf16)(vv.x >> 16); vd[560] = (bf16)(vv.y & 0xffffu); vd[840] = (bf16)(vv.y >> 16);
        vd[1120] = (bf16)(vv.z & 0xffffu); vd[1400] = (bf16)(vv.z >> 16); vd[1680] = (bf16)(vv.w & 0xffffu); vd[1960] = (bf16)(vv.w >> 16); }
    for (int it = tid; it < 64 * 24; it += 512) Vt[(it / 24) * 280 + 256 + (it % 24)] = 0;
    __syncthreads();
    const int g = wid >> 1, h = kvh * 4 + g, qh = wid & 1;
    const float slope = exp2f(-(float)(h + 1)), sink = p.in[8][h];
    for (int qt = 0; qt < 4; ++qt) {
        const int q0 = 64 * qh + 16 * qt;
        const size_t qrow = (size_t)(b * SEQ + 128 * nb + q0 + fr);
        const bf16x8 qf0 = *(const bf16x8*)(QA + qrow * 512 + h * 64 + 8 * fq), qf1 = *(const bf16x8*)(QA + qrow * 512 + h * 64 + 32 + 8 * fq);
        f32x4 sc[10]; float mx = sink;
#pragma unroll
        for (int kt = 0; kt < 9; ++kt) { const int ks0 = q0 + 16 * kt;
            f32x4 a = {0.f, 0.f, 0.f, 0.f};
            a = MFMA16(ldfrag(Ks, 72, ks0, 0, fr, fq), qf0, a); a = MFMA16(ldfrag(Ks, 72, ks0, 32, fr, fq), qf1, a);
#pragma unroll
            for (int i = 0; i < 4; ++i) { const int si = ks0 + 4 * fq + i, dist = 128 + q0 + fr - si;
                const bool ok = (dist >= 0) && (dist <= 128) && (nb > 0 || si >= 128);
                a[i] = ok ? a[i] * 0.125f - slope * (float)dist : -INFINITY; mx = fmaxf(mx, a[i]); }
            sc[kt] = a; }
        mx = fmaxf(mx, __shfl_xor(mx, 16)); mx = fmaxf(mx, __shfl_xor(mx, 32));
        float sum = 0.f;
#pragma unroll
        for (int kt = 0; kt < 9; ++kt)
#pragma unroll
            for (int i = 0; i < 4; ++i) { const float e = __expf(sc[kt][i] - mx); sc[kt][i] = e; sum += e; }
        sc[9] = (f32x4){0.f, 0.f, 0.f, 0.f};
        sum += __shfl_xor(sum, 16); sum += __shfl_xor(sum, 32);
        const float inv = 1.f / (sum + __expf(sink - mx));
        f32x4 o[4];
#pragma unroll
        for (int dt = 0; dt < 4; ++dt) o[dt] = (f32x4){0.f, 0.f, 0.f, 0.f};
#pragma unroll
        for (int s2 = 0; s2 < 5; ++s2) { const u32x2 p0 = pk4(sc[2 * s2]), p1 = pk4(sc[2 * s2 + 1]);
            u32x4 pv; pv.x = p0.x; pv.y = p0.y; pv.z = p1.x; pv.w = p1.y; const bf16x8 pb = __builtin_bit_cast(bf16x8, pv);
#pragma unroll
            for (int dt = 0; dt < 4; ++dt) { const LAS bf16* vp = Vt + (dt * 16 + fr) * 280 + q0 + 32 * s2 + 4 * fq;
                const u32x2 va = *(const LAS u32x2*)vp, vb = *(const LAS u32x2*)(vp + 16);
                u32x4 vv; vv.x = va.x; vv.y = va.y; vv.z = vb.x; vv.w = vb.y;
                o[dt] = MFMA16(__builtin_bit_cast(bf16x8, vv), pb, o[dt]); } }
#pragma unroll
        for (int dt = 0; dt < 4; ++dt) *(u32x2*)(MIX + qrow * 1024 + h * 64 + dt * 16 + 4 * fq) = pk4(o[dt] * inv);
    }
    __syncthreads();
}

DI void gdn_out_pair(const Params& p, int pair, int wid, int lane) {
    asm volatile("" : "+v"(lane));
    const int unit = pair * 2 + (wid >> 2), ct = wid & 3;
    const int c = unit >> 7, n = unit & 127, b = c >> 2, h = c & 3, fr = lane & 15, fq = lane >> 4;
    unsigned char* ws = p.ws;
    const bf16* QTo = (const bf16*)(ws + WS_QT) + (size_t)unit * 8192;
    const bf16* OBo = (const bf16*)(ws + WS_OB) + (size_t)unit * 8192;
    const bf16* SGo = (const bf16*)p.out + (size_t)unit * 16384;
    const int tokc = ct * 16 + fr; const size_t row = (size_t)(b * SEQ + n * 64 + tokc);
    bf16x8 qf[4];
#pragma unroll
    for (int s = 0; s < 4; ++s) qf[s] = *(const bf16x8*)(QTo + tokc * 128 + 32 * s + 8 * fq);
    u32x2 obv[8], zv[8];
#pragma unroll
    for (int t = 0; t < 8; ++t) { obv[t] = *(const u32x2*)(OBo + tokc * 128 + 16 * t + 4 * fq); zv[t] = *(const u32x2*)((const bf16*)(ws + WS_Z) + row * 512 + h * 128 + 16 * t + 4 * fq); }
    bf16x8 sf[8][4];
#pragma unroll
    for (int t = 0; t < 8; ++t)
#pragma unroll
        for (int s = 0; s < 4; ++s) sf[t][s] = *(const bf16x8*)(SGo + (16 * t + fr) * 128 + 32 * s + 8 * fq);
    f32x4 gnv[8];
#pragma unroll
    for (int t = 0; t < 8; ++t) gnv[t] = *(const f32x4*)(p.in[12] + 16 * t + 4 * fq);
    f32x4 o[8]; float ss = 0.f;
#pragma unroll
    for (int t = 0; t < 8; ++t) {
        f32x4 a = {bflo(obv[t].x), bfhi(obv[t].x), bflo(obv[t].y), bfhi(obv[t].y)};
#pragma unroll
        for (int s = 0; s < 4; ++s) a = MFMA16(sf[t][s], qf[s], a);
        o[t] = a; ss += (a[0] * a[0] + a[1] * a[1]) + (a[2] * a[2] + a[3] * a[3]); }
    ss += __shfl_xor(ss, 16); ss += __shfl_xor(ss, 32);
    const float rstd = 1.f / sqrtf(ss * (1.f / 128.f) + EPS);
    bf16* MIX = (bf16*)(ws + WS_MIX);
#pragma unroll
    for (int t = 0; t < 8; ++t) { const int e = 16 * t + 4 * fq;
        const f32x4 gn = gnv[t];
        f32x4 y; y[0] = o[t][0] * rstd * gn[0] * siluf(bflo(zv[t].x)); y[1] = o[t][1] * rstd * gn[1] * siluf(bfhi(zv[t].x)); y[2] = o[t][2] * rstd * gn[2] * siluf(bflo(zv[t].y)); y[3] = o[t][3] * rstd * gn[3] * siluf(bfhi(zv[t].y));
        *(u32x2*)(MIX + row * 1024 + 512 + h * 128 + e) = pk4(y); }
}

DI void sample_gdn_unit(const Params& p, LAS unsigned char* lds, int unit, int tid, int wid, int lane) {
    asm volatile("" : "+v"(tid), "+v"(lane));
    const int b = unit >> 2, h = unit & 3; const size_t row = MP + b;
    unsigned char* ws = p.ws;
    LAS float* qs = (LAS float*)lds; LAS float* ks = qs + 128; LAS float* vs = qs + 256; LAS float* red = qs + 384; LAS float* red2 = qs + 896; LAS float* ssw = qs + 1408;
    const bf16* QG = (const bf16*)(ws + WS_QG); const float* AB = (const float*)(ws + WS_AB);
    const int e = tid & 127, dg = tid >> 7;
    const float* S0 = p.in[5] + ((size_t)(b * 4 + h) * 128 + dg * 32) * 128 + e;
    float S[32];
#pragma unroll
    for (int i = 0; i < 32; ++i) S[i] = S0[i * 128];
    const float a_ab = AB[row * 8 + h], b_ab = AB[row * 8 + 4 + h], dtb = p.in[11][h], alog = p.in[10][h];
    const float zraw = bf2f(((const bf16*)(ws + WS_Z))[row * 512 + h * 128 + e]), gnv = p.in[12][e];
    float val = 0.f; const int prt = tid >> 7, d = tid & 127;
    if (tid < 384) { const int col = prt * 512 + h * 128 + d; const float* cw = p.in[9]; const float* sc = p.in[2] + (size_t)b * 3 * 1536 + col;
        const float y = cw[col] * sc[0] + cw[1536 + col] * sc[1536] + cw[3072 + col] * sc[3072] + cw[4608 + col] * bf2f(QG[row * 1536 + col]);
        val = siluf(y); const float s = wave_sum(val * val); if (lane == 0) ssw[wid] = s; }
    __syncthreads();
    if (tid < 384) { if (prt == 0) qs[d] = val * 0.08838834764831845f / sqrtf(ssw[0] + ssw[1] + EPS); else if (prt == 1) ks[d] = val / sqrtf(ssw[2] + ssw[3] + EPS); else vs[d] = val; }
    __syncthreads();
    const float xs = a_ab + dtb;
    const float g = -__expf(alog) * (fmaxf(xs, 0.f) + log1pf(__expf(-fabsf(xs))));
    const float beta = 1.f / (1.f + __expf(-b_ab)), eg = __expf(g);
    float kvp = 0.f;
#pragma unroll
    for (int i = 0; i < 32; ++i) { S[i] *= eg; kvp += ks[dg * 32 + i] * S[i]; }
    red[dg * 128 + e] = kvp;
    __syncthreads();
    const float u = (vs[e] - (red[e] + red[128 + e] + red[256 + e] + red[384 + e])) * beta;
    float* So = p.out + O_SSG + ((size_t)(b * 4 + h) * 128 + dg * 32) * 128 + e; float op = 0.f;
#pragma unroll
    for (int i = 0; i < 32; ++i) { S[i] += ks[dg * 32 + i] * u; op += qs[dg * 32 + i] * S[i]; So[i * 128] = S[i]; }
    red2[dg * 128 + e] = op;
    __syncthreads();
    float o = 0.f;
    if (tid < 128) { o = red2[e] + red2[128 + e] + red2[256 + e] + red2[384 + e]; const float s = wave_sum(o * o); if (lane == 0) ssw[8 + wid] = s; }
    __syncthreads();
    if (tid < 128) { const float rstd = 1.f / sqrtf((ssw[8] + ssw[9]) * (1.f / 128.f) + EPS);
        const float y = o * rstd * gnv * siluf(zraw);
        ((bf16*)(ws + WS_MIX))[row * 1024 + 512 + h * 128 + e] = (bf16)(pk2(y, 0.f) & 0xffffu); }
    __syncthreads();
}
DI void sample_attn_unit(const Params& p, LAS unsigned char* lds, int b, int tid, int wid, int lane) {
    asm volatile("" : "+v"(tid), "+v"(lane));
    unsigned char* ws = p.ws; const size_t row = MP + b;
    const bf16* QA = (const bf16*)(ws + WS_QA); const bf16* KV = (const bf16*)(ws + WS_KV);
    LAS float* Kl = (LAS float*)lds;
    LAS float* Vl = (LAS float*)(lds + 2 * 128 * 68 * 4);
    const float* kc = p.in[3] + (size_t)b * 16384; const float* vc = p.in[4] + (size_t)b * 16384;
    float* ok = p.out + O_SCK + (size_t)b * 16384; float* ov = p.out + O_SCV + (size_t)b * 16384;
    f32x4 kreg[8], vreg[8];
#pragma unroll
    for (int q = 0; q < 8; ++q) { const int i4 = tid + 512 * q; kreg[q] = *(const f32x4*)(kc + 4 * i4); vreg[q] = *(const f32x4*)(vc + 4 * i4); }
#pragma unroll
    for (int q = 0; q < 8; ++q) { const int i4 = tid + 512 * q, key = i4 >> 5, kvh = (i4 >> 4) & 1, d4 = (i4 & 15) * 4;
        *(LAS f32x4*)(Kl + (kvh * 128 + key) * 68 + d4) = kreg[q]; *(LAS f32x4*)(Vl + (kvh * 128 + key) * 68 + d4) = vreg[q];
        if (key >= 1) { *(f32x4*)(ok + 4 * i4 - 128) = kreg[q]; *(f32x4*)(ov + 4 * i4 - 128) = vreg[q]; } }
    if (tid < 32) { const u32x2 kn = *(const u32x2*)(KV + row * 256 + 4 * tid), vn = *(const u32x2*)(KV + row * 256 + 128 + 4 * tid);
        *(f32x4*)(ok + 127 * 128 + 4 * tid) = (f32x4){bflo(kn.x), bfhi(kn.x), bflo(kn.y), bfhi(kn.y)}; *(f32x4*)(ov + 127 * 128 + 4 * tid) = (f32x4){bflo(vn.x), bfhi(vn.x), bflo(vn.y), bfhi(vn.y)}; }
    __syncthreads();
    const int h = wid, kvh = h >> 2;
    const float slope = exp2f(-(float)(h + 1)), sink = p.in[8][h];
    const LAS float* Kh = Kl + kvh * 128 * 68; const LAS float* Vh = Vl + kvh * 128 * 68;
    float s0 = 0.f, s1 = 0.f, s2 = 0.f;
#pragma unroll
    for (int c4 = 0; c4 < 16; ++c4) { const u32x2 qv = *(const u32x2*)(QA + row * 512 + h * 64 + 4 * c4);
        const float q0 = bflo(qv.x), q1 = bfhi(qv.x), q2 = bflo(qv.y), q3 = bfhi(qv.y);
        const f32x4 k0 = *(const LAS f32x4*)(Kh + lane * 68 + 4 * c4), k1 = *(const LAS f32x4*)(Kh + (lane + 64) * 68 + 4 * c4);
        const u32x2 kn = *(const u32x2*)(KV + row * 256 + kvh * 64 + 4 * c4);
        s0 += q0 * k0[0] + q1 * k0[1] + q2 * k0[2] + q3 * k0[3]; s1 += q0 * k1[0] + q1 * k1[1] + q2 * k1[2] + q3 * k1[3];
        s2 += q0 * bflo(kn.x) + q1 * bfhi(kn.x) + q2 * bflo(kn.y) + q3 * bfhi(kn.y); }
    s0 = s0 * 0.125f - slope * (float)(128 - lane); s1 = s1 * 0.125f - slope * (float)(64 - lane); s2 = s2 * 0.125f;
    float mx = fmaxf(fmaxf(s0, s1), fmaxf(s2, sink));
#pragma unroll
    for (int o = 1; o < 64; o <<= 1) mx = fmaxf(mx, __shfl_xor(mx, o));
    const float p0 = __expf(s0 - mx), p1 = __expf(s1 - mx), p2 = __expf(s2 - mx);
    const float inv = 1.f / (wave_sum(p0 + p1) + p2 + __expf(sink - mx));
    float o = p2 * bf2f(KV[row * 256 + 128 + kvh * 64 + lane]);
#pragma unroll
    for (int j = 0; j < 64; ++j) { o += __int_as_float(__builtin_amdgcn_readlane(__float_as_int(p0), j)) * Vh[j * 68 + lane] + __int_as_float(__builtin_amdgcn_readlane(__float_as_int(p1), j)) * Vh[(j + 64) * 68 + lane]; }
    ((bf16*)(ws + WS_MIX))[row * 1024 + h * 64 + lane] = (bf16)(pk2(o * inv, 0.f) & 0xffffu);
    __syncthreads();
}
DI void state_copies(const Params& p, int gtid, int nthr) {
    unsigned char* ws = p.ws; const bf16* QG = (const bf16*)(ws + WS_QG); const bf16* KV = (const bf16*)(ws + WS_KV);
    for (int idx = gtid; idx < 9216; idx += nthr) { const int b = idx / 4608, i = (idx % 4608) / 1536, ch = idx % 1536; p.out[O_PSC + idx] = bf2f(QG[(size_t)(b * SEQ + SEQ - 3 + i) * 1536 + ch]); }
    for (int idx = gtid; idx < 32768; idx += nthr) { const int b = idx >> 14, j = (idx >> 7) & 127, cc = idx & 127; const size_t r = (size_t)(b * SEQ + SEQ - 128 + j) * 256;
        p.out[O_PCK + idx] = bf2f(KV[r + cc]); p.out[O_PCV + idx] = bf2f(KV[r + 128 + cc]); }
    for (int idx = gtid; idx < 589824; idx += nthr) { const int b = idx / 4608, i = (idx % 4608) / 1536, ch = idx % 1536;
        p.out[O_SSC + idx] = i < 2 ? p.in[2][(size_t)(b * 3 + i + 1) * 1536 + ch] : bf2f(QG[(size_t)(MP + b) * 1536 + ch]); }
}

DI void norm_rows_mid(const Params& p, int gw, int NGW, int lane) {
    asm volatile("" : "+v"(lane));
    unsigned char* ws = p.ws; const bf16* T1 = (const bf16*)(ws + WS_T1); bf16* XN = (bf16*)(ws + WS_XN); bf16* X1B = (bf16*)(ws + WS_MIX);
    f32x4 g1[4], g2[4];
#pragma unroll
    for (int j = 0; j < 4; ++j) { g1[j] = *(const f32x4*)(p.in[14] + 4 * lane + 256 * j); g2[j] = *(const f32x4*)(p.in[15] + 4 * lane + 256 * j); }
    f32x4 nt[4], nxx[4];
    { const int m0 = gw < MR ? gw : 0; const float* xr0 = m0 < MP ? p.in[0] + (size_t)m0 * D : p.in[1] + (size_t)(m0 - MP) * D;
#pragma unroll
      for (int j = 0; j < 4; ++j) { { const u32x2 tb = *(const u32x2*)(T1 + (size_t)m0 * D + 4 * lane + 256 * j); nt[j] = (f32x4){bflo(tb.x), bfhi(tb.x), bflo(tb.y), bfhi(tb.y)}; } nxx[j] = *(const f32x4*)(xr0 + 4 * lane + 256 * j); } }
    for (int m = gw; m < MR; m += NGW) {
        f32x4 t[4], x[4]; float s = 0.f;
#pragma unroll
        for (int j = 0; j < 4; ++j) { t[j] = nt[j]; x[j] = nxx[j]; s += (t[j][0] * t[j][0] + t[j][1] * t[j][1]) + (t[j][2] * t[j][2] + t[j][3] * t[j][3]); }
        { const int mn = (m + NGW < MR) ? m + NGW : m; const float* xrn = mn < MP ? p.in[0] + (size_t)mn * D : p.in[1] + (size_t)(mn - MP) * D;
#pragma unroll
          for (int j = 0; j < 4; ++j) { { const u32x2 tb = *(const u32x2*)(T1 + (size_t)mn * D + 4 * lane + 256 * j); nt[j] = (f32x4){bflo(tb.x), bfhi(tb.x), bflo(tb.y), bfhi(tb.y)}; } nxx[j] = *(const f32x4*)(xrn + 4 * lane + 256 * j); } }
        const float rstd = 1.f / sqrtf(wave_sum(s) * (1.f / D) + EPS); float s2 = 0.f;
#pragma unroll
        for (int j = 0; j < 4; ++j) { x[j] = x[j] + t[j] * rstd * g1[j]; *(u32x2*)(X1B + (size_t)m * D + 4 * lane + 256 * j) = pk4(x[j]); s2 += (x[j][0] * x[j][0] + x[j][1] * x[j][1]) + (x[j][2] * x[j][2] + x[j][3] * x[j][3]); }
        const float rstd2 = 1.f / sqrtf(wave_sum(s2) * (1.f / D) + EPS);
#pragma unroll
        for (int j = 0; j < 4; ++j) *(u32x2*)(XN + (size_t)m * D + 4 * lane + 256 * j) = pk4(x[j] * rstd2 * g2[j]);
    }
}
DI void norm_rows_fin(const Params& p, int gw, int NGW, int lane) {
    asm volatile("" : "+v"(lane));
    const bf16* T2 = (const bf16*)(p.ws + WS_T2); const bf16* X1B = (const bf16*)(p.ws + WS_MIX);
    f32x4 g1[4];
#pragma unroll
    for (int j = 0; j < 4; ++j) g1[j] = *(const f32x4*)(p.in[18] + 4 * lane + 256 * j);
    f32x4 nt[4], nxx[4];
    { const int m0 = gw < MR ? gw : 0;
#pragma unroll
      for (int j = 0; j < 4; ++j) { { const u32x2 tb = *(const u32x2*)(T2 + (size_t)m0 * D + 4 * lane + 256 * j); nt[j] = (f32x4){bflo(tb.x), bfhi(tb.x), bflo(tb.y), bfhi(tb.y)}; } { const u32x2 xb = *(const u32x2*)(X1B + (size_t)m0 * D + 4 * lane + 256 * j); nxx[j] = (f32x4){bflo(xb.x), bfhi(xb.x), bflo(xb.y), bfhi(xb.y)}; } } }
    for (int m = gw; m < MR; m += NGW) {
        f32x4 t[4], x[4]; float s = 0.f;
#pragma unroll
        for (int j = 0; j < 4; ++j) { t[j] = nt[j]; x[j] = nxx[j]; s += (t[j][0] * t[j][0] + t[j][1] * t[j][1]) + (t[j][2] * t[j][2] + t[j][3] * t[j][3]); }
        { const int mn = (m + NGW < MR) ? m + NGW : m;
#pragma unroll
          for (int j = 0; j < 4; ++j) { { const u32x2 tb = *(const u32x2*)(T2 + (size_t)mn * D + 4 * lane + 256 * j); nt[j] = (f32x4){bflo(tb.x), bfhi(tb.x), bflo(tb.y), bfhi(tb.y)}; } { const u32x2 xb = *(const u32x2*)(X1B + (size_t)mn * D + 4 * lane + 256 * j); nxx[j] = (f32x4){bflo(xb.x), bfhi(xb.x), bflo(xb.y), bfhi(xb.y)}; } } }
        const float rstd = 1.f / sqrtf(wave_sum(s) * (1.f / D) + EPS);
#pragma unroll
        for (int j = 0; j < 4; ++j) *(f32x4*)(p.out + (size_t)m * D + 4 * lane + 256 * j) = x[j] + t[j] * rstd * g1[j];
    }
}

#define XB_TMO      128
#define XB_XCNT(j)  (256  + 64 * (j))
#define XB_XSUB(j)  (1280 + 64 * (j))
#define XB_XGEN(j)  (2304 + 64 * (j))
#define XB_TOP      3328
#define XB_TOPGEN   3392
#define XCD_BAR_WORDS 3456
#define XB_SPIN_CAP (1u << 18)

__device__ __forceinline__ unsigned xb_ld(unsigned* p)              { return __hip_atomic_load(p, __ATOMIC_RELAXED, __HIP_MEMORY_SCOPE_AGENT); }
__device__ __forceinline__ unsigned xb_add(unsigned* p, unsigned v) { return __hip_atomic_fetch_add(p, v, __ATOMIC_RELAXED, __HIP_MEMORY_SCOPE_AGENT); }
__device__ __forceinline__ unsigned xb_xcc_id() { return (unsigned)__builtin_amdgcn_s_getreg((3 << 11) | 20) & 0xFu; }
#define XB_SPIN(cond, bar) do { unsigned _sp = 0; while (cond) { __builtin_amdgcn_s_sleep(1); \
    if ((++_sp & 255u) == 0u) { if (xb_ld(&(bar)[XB_TMO])) break; if (_sp > XB_SPIN_CAP) { atomicAdd(&(bar)[XB_TMO], 1u); break; } } } } while (0)

struct XcdBarrier {
    unsigned* bar; unsigned x;
    volatile LAS unsigned* st;
};

__device__ __forceinline__ XcdBarrier xcd_barrier_post(unsigned* bar, volatile LAS unsigned* st) {
    XcdBarrier b; b.bar = bar; b.x = xb_xcc_id(); b.st = st;
    if (threadIdx.x == 0) (void)xb_add(&bar[XB_XCNT(b.x)], 1u);
    return b;
}
__device__ __forceinline__ void xcd_barrier_complete(unsigned* bar, unsigned x, unsigned& nloc, unsigned& nx) {
    const unsigned G = gridDim.x * gridDim.y * gridDim.z;
    unsigned sum, cnt, mine, sp = 0u;
    for (;;) {
        sum = 0u; cnt = 0u; mine = 0u;
#pragma unroll
        for (unsigned j = 0; j < 16; ++j) { const unsigned c = xb_ld(&bar[XB_XCNT(j)]); sum += c; cnt += (c > 0u) ? 1u : 0u; mine = (j == x) ? c : mine; }
        if (sum == G) break;
        __builtin_amdgcn_s_sleep(1);
        if ((++sp & 255u) == 0u) { if (xb_ld(&bar[XB_TMO])) break; if (sp > XB_SPIN_CAP) { atomicAdd(&bar[XB_TMO], 1u); break; } }
    }
    nloc = mine > 0u ? mine : 1u; nx = cnt > 0u ? cnt : 1u;
}

__device__ __forceinline__ void xcd_barrier(const XcdBarrier& b) {
    asm volatile("s_waitcnt vmcnt(0)" ::: "memory");
    __syncthreads();
    if (threadIdx.x == 0) {
        unsigned* bar = b.bar;
        __builtin_amdgcn_s_waitcnt(0);
        unsigned nloc = b.st[0], nx = b.st[1];
        if (nloc == 0u) { xcd_barrier_complete(bar, b.x, nloc, nx); b.st[0] = nloc; b.st[1] = nx; }
        const unsigned old = xb_add(&bar[XB_XSUB(b.x)], 1u);
        const unsigned gen = old / nloc;
        if (old + 1u == (gen + 1u) * nloc) {
            __builtin_amdgcn_fence(__ATOMIC_RELEASE, "agent");
            asm volatile("s_waitcnt vmcnt(0)" ::: "memory");
            const unsigned og = xb_add(&bar[XB_TOP], 1u);
            const unsigned tg = og / nx;
            if (og + 1u == (tg + 1u) * nx) xb_add(&bar[XB_TOPGEN], 1u);
            else XB_SPIN(xb_ld(&bar[XB_TOPGEN]) == tg, bar);
            __builtin_amdgcn_fence(__ATOMIC_ACQUIRE, "agent");
            xb_add(&bar[XB_XGEN(b.x)], 1u);
            asm volatile("s_waitcnt vmcnt(0)" ::: "memory");
        } else {
            XB_SPIN(xb_ld(&bar[XB_XGEN(b.x)]) == gen, bar);
            __builtin_amdgcn_fence(__ATOMIC_ACQUIRE, "agent");
            asm volatile("s_waitcnt vmcnt(0)" ::: "memory");
        }
    }
    __syncthreads();
}

struct StoreF32 { float* O; int ldc; DI void operator()(int r, int c, float v) const { O[(size_t)r * ldc + c] = v; } };
struct StoreBf16 { bf16* O; int ldc; DI void operator()(int r, int c, float v) const { O[(size_t)r * ldc + c] = (bf16)(pk2(v, 0.f) & 0xffffu); } };
struct StoreRelu2 { bf16* O; int ldc; DI void operator()(int r, int c, float v) const { const float a = fmaxf(v, 0.f); O[(size_t)r * ldc + c] = (bf16)(pk2(a * a, 0.f) & 0xffffu); } };
template <int TMT, int TNT, class Store>
DI void small_gemm_tile(const bf16* A, const bf16* Bt, int K, int row0, int col0, LAS float* part, int tid, int wid, int lane, const Store& st) {
    asm volatile("" : "+v"(tid), "+v"(lane));
    const int fr = lane & 15, fq = lane >> 4, ks = K >> 3;
    f32x4 acc[TMT][TNT];
#pragma unroll
    for (int m = 0; m < TMT; ++m)
#pragma unroll
        for (int n = 0; n < TNT; ++n) acc[m][n] = (f32x4){0.f, 0.f, 0.f, 0.f};
    const bf16* ap = A + (size_t)(row0 + fr) * K + wid * ks + 8 * fq;
    const bf16* bp = Bt + (size_t)(col0 + fr) * K + wid * ks + 8 * fq;
#pragma unroll 4
    for (int k = 0; k < ks; k += 32) {
        bf16x8 a[TMT], b[TNT];
#pragma unroll
        for (int m = 0; m < TMT; ++m) a[m] = *(const bf16x8*)(ap + (size_t)m * 16 * K + k);
#pragma unroll
        for (int n = 0; n < TNT; ++n) b[n] = *(const bf16x8*)(bp + (size_t)n * 16 * K + k);
#pragma unroll
        for (int m = 0; m < TMT; ++m)
#pragma unroll
            for (int n = 0; n < TNT; ++n) acc[m][n] = MFMA16(a[m], b[n], acc[m][n]);
    }
    constexpr int TM = TMT * 16, TN = TNT * 16;
#pragma unroll
    for (int m = 0; m < TMT; ++m)
#pragma unroll
        for (int n = 0; n < TNT; ++n)
#pragma unroll
            for (int i = 0; i < 4; ++i) part[(wid * TM + m * 16 + 4 * fq + i) * TN + n * 16 + fr] = acc[m][n][i];
    __syncthreads();
    for (int idx = tid; idx < TM * TN; idx += 512) { const int r = idx / TN, c = idx % TN; float v = 0.f;
#pragma unroll
        for (int w = 0; w < 8; ++w) v += part[(w * TM + r) * TN + c];
        st(row0 + r, col0 + c, v); }
    __syncthreads();
}

__global__ void __launch_bounds__(512, 2) fwd_megakernel(Params p) {
    extern __shared__ __attribute__((aligned(16))) unsigned char lds_raw[];
    LAS unsigned char* lds = (LAS unsigned char*)lds_raw;
    cg::grid_group grid = cg::this_grid();
    const int wid = __builtin_amdgcn_readfirstlane(threadIdx.x >> 6);
#define FRESH int tid = threadIdx.x; asm volatile("" : "+v"(tid)); int lane = tid & 63; (void)lane
    const int G = gridDim.x, bx = blockIdx.x;
    if (threadIdx.x < 16) ((LAS unsigned*)(lds + LDS_CTL))[threadIdx.x] = 0u;
    __syncthreads();
    XcdBarrier xbar = xcd_barrier_post((unsigned*)(p.ws + WS_BAR), (volatile LAS unsigned*)(lds + LDS_CTL));
#define GSYNC() do { if (p.use_cg) grid.sync(); else xcd_barrier(xbar); } while (0)
    const int gw = bx * 8 + wid, NGW = G * 8;
    unsigned char* ws = p.ws;
#ifndef PHM
#define PHM 0xFFFF
#endif
    { FRESH; if (PHM & 1) p0_prologue(p, lds, gw, NGW, wid, lane); }
    GSYNC();
    if (PHM & 2) { pg8::Gemm g{(const pg8::bf16_t*)(ws + WS_XN), (const pg8::bf16_t*)(ws + WS_WIN), MPAD, NIN, D}; pg8::StaticOrder S; S.init(MPAD, NIN, G, bx);
      pg8::EpiInProj E{(pg8::bf16_t*)(ws + WS_QA), (pg8::bf16_t*)(ws + WS_KV), (pg8::bf16_t*)(ws + WS_QG), (pg8::bf16_t*)(ws + WS_Z)};
      pg8::gemm_phase<pg8::EpiInProj, pg8::StaticOrder, true, true>(lds, g, S, E); }
    { FRESH; const int nfull = (MPAD / 256) * (NIN / 256) % G;
      if (nfull != 0 && bx >= nfull) late_transposes(p, lds, (bx - nfull) * 8 + wid, (G - nfull) * 8, wid, lane);
      else if (nfull == 0) late_transposes(p, lds, gw, NGW, wid, lane); }
    GSYNC();
    { FRESH; if ((G & 7) == 0) { const int per = G >> 3;
          for (int n = bx >> 3; n < 64; n += per) { if (PHM & 4) gdn_prep_unit(p, lds, (bx & 7) * 128 + n, tid, wid, lane); } }
      else for (int u = bx; u < 512; u += G) { if (PHM & 4) gdn_prep_unit(p, lds, (u >> 6) * 128 + (u & 63), tid, wid, lane); } }
    { FRESH; state_copies(p, bx * 512 + tid, G * 512); }
    GSYNC();
    { FRESH; if (bx < 64) { if (PHM & 32) scan_phase<0>(p, lds, bx, wid, lane); }
    else if ((G & 7) == 0) { const int per = (G - 64) >> 3;
        for (int n = (bx - 64) >> 3; n < 64; n += per) { if (PHM & 4) gdn_prep_unit(p, lds, (bx & 7) * 128 + 64 + n, tid, wid, lane); } }
    else for (int u = bx - 64; u < 512; u += G - 64) { if (PHM & 4) gdn_prep_unit(p, lds, (u >> 6) * 128 + 64 + (u & 63), tid, wid, lane); } }
    GSYNC();
    { FRESH; if (bx < 64) { if (PHM & 32) scan_phase<1>(p, lds, bx, wid, lane); }
    else for (int u = bx - 64; u < 896; u += G - 64) {
        if (u < 256) { if (PHM & 64) attn_unit(p, lds, u, tid, wid, lane); }
        else if (u < 768) { if (PHM & 8) sample_gdn_unit(p, lds, u - 256, tid, wid, lane); }
        else { if (PHM & 16) sample_attn_unit(p, lds, u - 768, tid, wid, lane); } } }
    GSYNC();
    { FRESH; if ((G & 7) == 0) { const int per = G >> 3;
          for (int j = bx >> 3; j < 64; j += per) { if (PHM & 128) gdn_out_pair(p, (bx & 7) * 64 + j, wid, lane); } }
      else for (int u = bx; u < 512; u += G) { if (PHM & 128) gdn_out_pair(p, u, wid, lane); } }
    GSYNC();
    if (PHM & 256) { pg8::Gemm g{(const pg8::bf16_t*)(ws + WS_MIX), (const pg8::bf16_t*)(ws + WS_WOUT), MP, D, D}; pg8::StaticOrder S; S.init(MP, D, G, bx);
      pg8::EpiBf16p E{(pg8::bf16_t*)(ws + WS_T1), D};
      pg8::gemm_phase<pg8::EpiBf16p, pg8::StaticOrder, true, true>(lds, g, S, E); }
    { FRESH; for (int t = bx; t < 256; t += G) small_gemm_tile<1, 2>((const bf16*)(ws + WS_MIX), (const bf16*)(ws + WS_WOUT), D, MP + (t >> 5) * 16, (t & 31) * 32, (LAS float*)lds, tid, wid, lane, StoreBf16{(bf16*)(ws + WS_T1), D}); }
    GSYNC();
    { FRESH; if (PHM & 512) norm_rows_mid(p, gw, NGW, lane); }
    GSYNC();
    if (PHM & 1024) { pg8::Gemm g{(const pg8::bf16_t*)(ws + WS_XN), (const pg8::bf16_t*)(ws + WS_WUP), MP, FF, D}; pg8::StaticOrder S; S.init(MP, FF, G, bx);
      pg8::EpiRelu2 E{(pg8::bf16_t*)(ws + WS_H), FF};
      pg8::gemm_phase<pg8::EpiRelu2, pg8::StaticOrder, true, true>(lds, g, S, E); }
    { FRESH; for (int t = bx; t < 256; t += G) small_gemm_tile<2, 4>((const bf16*)(ws + WS_XN), (const bf16*)(ws + WS_WUP), D, MP + (t >> 6) * 32, (t & 63) * 64, (LAS float*)lds, tid, wid, lane, StoreRelu2{(bf16*)(ws + WS_H), FF}); }
    GSYNC();
    if (PHM & 2048) { pg8::Gemm g{(const pg8::bf16_t*)(ws + WS_H), (const pg8::bf16_t*)(ws + WS_WDN), MP, D, FF}; pg8::StaticOrder S; S.init(MP, D, G, bx);
      pg8::EpiBf16p E{(pg8::bf16_t*)(ws + WS_T2), D};
      pg8::gemm_phase<pg8::EpiBf16p, pg8::StaticOrder, true, true>(lds, g, S, E); }
    { FRESH; for (int t = bx; t < 256; t += G) small_gemm_tile<1, 2>((const bf16*)(ws + WS_H), (const bf16*)(ws + WS_WDN), FF, MP + (t >> 5) * 16, (t & 31) * 32, (LAS float*)lds, tid, wid, lane, StoreBf16{(bf16*)(ws + WS_T2), D}); }
    GSYNC();
    { FRESH; if (PHM & 4096) norm_rows_fin(p, gw, NGW, lane); }
}

extern "C" void kernel_launch(void* const* d_in, const int* in_sizes, int n_in, void* d_out, int out_size, void* d_ws, size_t ws_size, hipStream_t stream) {
    static int grid = 0;
    if (grid == 0) {
        if (n_in != 19 || ws_size < WS_END) { fprintf(stderr, "kernel_launch: unexpected n_in %d / ws_size %zu\n", n_in, ws_size); grid = -1; return; }
        int dev = 0, cus = 0, per_cu = 0;
        hipGetDevice(&dev); hipDeviceGetAttribute(&cus, hipDeviceAttributeMultiprocessorCount, dev);
        if (hipFuncSetAttribute((const void*)fwd_megakernel, hipFuncAttributeMaxDynamicSharedMemorySize, LDS_BYTES) != hipSuccess) { fprintf(stderr, "kernel_launch: hipFuncSetAttribute failed\n"); }
        hipOccupancyMaxActiveBlocksPerMultiprocessor(&per_cu, (const void*)fwd_megakernel, 512, LDS_BYTES);
        (void)hipGetLastError();
        if (per_cu < 1) { fprintf(stderr, "kernel_launch: occupancy query says %d blocks/CU\n", per_cu); per_cu = 1; }
        grid = cus;
        if (grid < 65) { fprintf(stderr, "kernel_launch: grid %d too small\n", grid); grid = -1; return; }
    }
    if (grid < 0) return;
    Params p{};
    for (int i = 0; i < 19; ++i) p.in[i] = (const float*)d_in[i];
    p.out = (float*)d_out; p.ws = (unsigned char*)d_ws; p.use_cg = 0; p.pad = 0;
    (void)hipMemsetAsync((unsigned char*)d_ws + WS_BAR, 0, 16384, stream);
    void* args[] = {&p};
    hipError_t e = hipLaunchCooperativeKernel((const void*)fwd_megakernel, dim3(grid), dim3(512), args, LDS_BYTES, stream);
    if (e != hipSuccess) fprintf(stderr, "cooperative launch failed: %s (grid %d)\n", hipGetErrorString(e), grid);
}
```

```cpp
#include <hip/hip_runtime.h>
#include <hip/hip_cooperative_groups.h>
#include <cstdio>
#include <cstdint>
namespace cg = cooperative_groups;
namespace pg8 {
#define PG8_LAS __attribute__((address_space(3)))
typedef unsigned short bf16_t;
typedef short bf16x8 __attribute__((ext_vector_type(8)));
typedef float f32x4 __attribute__((ext_vector_type(4)));
typedef unsigned u32x4 __attribute__((ext_vector_type(4)));
constexpr int BM = 256, BK = 64, HALF = 128, HTB = HALF * BK * 2  , STAGE_BYTES = 8 * HTB, NXCD = 8, WGM = 2;

__host__ __device__ __forceinline__ int lds_byte(int r, int c) { const int st = (r >> 4) * 2 + (c >> 5), rr = r & 15, cc = c & 31, ob = rr * 64 + cc * 2; return st * 1024 + (ob ^ (((ob >> 9) & 1) << 5)); }
__host__ __device__ __forceinline__ void stage_rc(int b, int& R, int& C) { const int st = b / 1024, sb = b % 1024, swz = sb ^ (((sb >> 9) & 1) << 5); R = (st >> 1) * 16 + swz / 64; C = (st & 1) * 32 + (swz % 64) / 2; }
__host__ __device__ __forceinline__ int perm32(int rho) { const int n = rho >> 4, i = rho & 15; return 8 * (i >> 2) + 4 * n + (i & 3); }

struct Unit { int pm, pn; };
struct Gemm { const bf16_t* A; const bf16_t* Bt; int M, N, K; };

struct StaticOrder {
    int nM, nN, nwg, G, c;
    __host__ __device__ void init(int M, int N, int G_, int c_) { nM = M / BM; nN = N / BM; nwg = nM * nN; G = G_; c = c_; }
    __host__ __device__ bool next(int i, Unit& u) const {
        const long L = (long)i * G + c; if (L >= nwg) return false;
        int wgid = (int)L; { const int q = nwg / NXCD, r = nwg % NXCD, xcd = wgid % NXCD, off = wgid / NXCD; wgid = (xcd < r ? xcd * (q + 1) : r * (q + 1) + (xcd - r) * q) + off; }
        const int nig = WGM * nN, gid = wgid / nig, fm = gid * WGM, gsz = (nM - fm) < WGM ? (nM - fm) : WGM;
        u.pm = fm + ((wgid % nig) % gsz); u.pn = (wgid % nig) / gsz; return true;
    }
    __device__ __forceinline__ void a_ready(const Unit&) const {}
    __device__ __forceinline__ void done(const Unit&) const {}
};

typedef unsigned u32x2e __attribute__((ext_vector_type(2)));
typedef __bf16 bf2e_t __attribute__((ext_vector_type(2)));
typedef float f32x2e __attribute__((ext_vector_type(2)));
__device__ __forceinline__ unsigned cvt_pk_bf16(float lo, float hi) { f32x2e v = {lo, hi}; return __builtin_bit_cast(unsigned, __builtin_convertvector(v, bf2e_t)); }
struct EpiInProj {
    static constexpr bool PERM = true, AFTER_DRAIN = false;
    bf16_t *QA, *KV, *QG, *Z;
    __device__ __forceinline__ void operator()(const f32x4 (&acc)[2][2][4][2], const Unit& u, int wr, int wc, int fr, int fq) const {
        const int pn = u.pn; bf16_t* base; int ldc, colt;
        if (pn < 2) { base = QA; ldc = 512; colt = pn * 256; } else if (pn == 2) { base = KV; ldc = 256; colt = 0; } else if (pn < 9) { base = QG; ldc = 1536; colt = (pn - 3) * 256; } else { base = Z; ldc = 512; colt = (pn - 9) * 256; }
        const int row0 = u.pm * BM + wr * 64 + fr, col0 = colt + wc * 32 + 8 * fq;
#pragma unroll
        for (int ai = 0; ai < 2; ++ai)
#pragma unroll
            for (int m = 0; m < 4; ++m) { bf16_t* rowp = base + (size_t)(row0 + ai * HALF + m * 16) * ldc + col0;
#pragma unroll
                for (int bj = 0; bj < 2; ++bj) { const f32x4 v0 = acc[ai][bj][m][0], v1 = acc[ai][bj][m][1];
                    u32x4 w; w.x = cvt_pk_bf16(v0[0], v0[1]); w.y = cvt_pk_bf16(v0[2], v0[3]); w.z = cvt_pk_bf16(v1[0], v1[1]); w.w = cvt_pk_bf16(v1[2], v1[3]);
                    *(u32x4*)(rowp + bj * HALF) = w; } }
    }
};
struct EpiRelu2 {
    static constexpr bool PERM = true, AFTER_DRAIN = false;
    bf16_t* O; int ldc;
    __device__ __forceinline__ void operator()(const f32x4 (&acc)[2][2][4][2], const Unit& u, int wr, int wc, int fr, int fq) const {
        const int row0 = u.pm * BM + wr * 64 + fr, col0 = u.pn * BM + wc * 32 + 8 * fq;
#pragma unroll
        for (int ai = 0; ai < 2; ++ai)
#pragma unroll
            for (int m = 0; m < 4; ++m) { bf16_t* rowp = O + (size_t)(row0 + ai * HALF + m * 16) * ldc + col0;
#pragma unroll
                for (int bj = 0; bj < 2; ++bj) { f32x4 v0 = acc[ai][bj][m][0], v1 = acc[ai][bj][m][1];
#pragma unroll
                    for (int e = 0; e < 4; ++e) { const float a = fmaxf(v0[e], 0.f), b = fmaxf(v1[e], 0.f); v0[e] = a * a; v1[e] = b * b; }
                    u32x4 w; w.x = cvt_pk_bf16(v0[0], v0[1]); w.y = cvt_pk_bf16(v0[2], v0[3]); w.z = cvt_pk_bf16(v1[0], v1[1]); w.w = cvt_pk_bf16(v1[2], v1[3]);
                    *(u32x4*)(rowp + bj * HALF) = w; } }
    }
};
struct EpiBf16p {
    static constexpr bool PERM = true, AFTER_DRAIN = false;
    bf16_t* O; int ldc;
    __device__ __forceinline__ void operator()(const f32x4 (&acc)[2][2][4][2], const Unit& u, int wr, int wc, int fr, int fq) const {
        const int row0 = u.pm * BM + wr * 64 + fr, col0 = u.pn * BM + wc * 32 + 8 * fq;
#pragma unroll
        for (int ai = 0; ai < 2; ++ai)
#pragma unroll
            for (int m = 0; m < 4; ++m) { bf16_t* rowp = O + (size_t)(row0 + ai * HALF + m * 16) * ldc + col0;
#pragma unroll
                for (int bj = 0; bj < 2; ++bj) { f32x4 v0 = acc[ai][bj][m][0], v1 = acc[ai][bj][m][1];
                    u32x4 w; w.x = cvt_pk_bf16(v0[0], v0[1]); w.y = cvt_pk_bf16(v0[2], v0[3]); w.z = cvt_pk_bf16(v1[0], v1[1]); w.w = cvt_pk_bf16(v1[2], v1[3]);
                    *(u32x4*)(rowp + bj * HALF) = w; } }
    }
};
struct EpiF32 {
    static constexpr bool PERM = true, AFTER_DRAIN = false;
    float* O; int ldc;
    __device__ __forceinline__ void operator()(const f32x4 (&acc)[2][2][4][2], const Unit& u, int wr, int wc, int fr, int fq) const {
        const int row0 = u.pm * BM + wr * 64 + fr, col0 = u.pn * BM + wc * 32 + 8 * fq;
#pragma unroll
        for (int ai = 0; ai < 2; ++ai)
#pragma unroll
            for (int m = 0; m < 4; ++m) { float* rowp = O + (size_t)(row0 + ai * HALF + m * 16) * ldc + col0;
#pragma unroll
                for (int bj = 0; bj < 2; ++bj) { *(f32x4*)(rowp + bj * HALF) = acc[ai][bj][m][0]; *(f32x4*)(rowp + bj * HALF + 4) = acc[ai][bj][m][1]; } }
    }
};
template <class Epi, class Sched, bool ALIGN_EPI = false, bool SP2 = false>
__device__ __forceinline__ void gemm_phase(PG8_LAS unsigned char* lds, const Gemm g, const Sched& S, const Epi& E) {
    int tid_ = threadIdx.x; asm volatile("" : "+v"(tid_));
    const int tid = tid_, wid = __builtin_amdgcn_readfirstlane(tid >> 6), lane = tid & 63, wr = wid >> 2, wc = wid & 3, fr = lane & 15, fq = lane >> 4;
    const int K = g.K, nt = K / BK;
    unsigned voffA[2], voffB[2];
#pragma unroll
    for (int i = 0; i < 2; ++i) { int R, C; stage_rc(tid * 16 + i * 8192, R, C); const int Rb = Epi::PERM ? ((R & ~31) + perm32(R & 31)) : R;
        voffA[i] = (unsigned)(R * K + C) * 2u; voffB[i] = (unsigned)(Rb * K + C) * 2u; }
    const size_t kstep = (size_t)(BK * 2);
    const size_t hstep = (size_t)HALF * K * 2;
    const size_t tstep = 2 * hstep;
    const unsigned ldsw = (unsigned)wid * 1024u;
    const int aoff = lds_byte(wr * 64 + fr, fq * 8), boff = lds_byte(wc * 32 + fr, fq * 8);
#define PG8_SA(b, h) (((b) * 2 + (h)) * HTB)
#define PG8_SB(b, h) ((4 + (b) * 2 + (h)) * HTB)
#define PG8_STAGE(bufoff, gbase, voff) do { _Pragma("unroll") for (int _i = 0; _i < 2; ++_i) \
        __builtin_amdgcn_global_load_lds((const unsigned*)((const char*)(gbase) + (voff)[_i]), (PG8_LAS unsigned*)(lds + (bufoff) + ldsw + _i * 8192), 16, 0, 0); } while (0)
#define PG8_LDA(dst, b, h) do { _Pragma("unroll") for (int m = 0; m < 4; ++m) _Pragma("unroll") for (int k = 0; k < 2; ++k) dst[m][k] = *(const PG8_LAS bf16x8*)(lds + PG8_SA(b, h) + aoff + m * 2048 + k * 1024); } while (0)
#define PG8_LDB(dst, b, h) do { _Pragma("unroll") for (int n = 0; n < 2; ++n) _Pragma("unroll") for (int k = 0; k < 2; ++k) dst[n][k] = *(const PG8_LAS bf16x8*)(lds + PG8_SB(b, h) + boff + n * 2048 + k * 1024); } while (0)
#define PG8_MMA(ai, bj, At, Bt) do { __builtin_amdgcn_s_setprio(1); _Pragma("unroll") for (int m = 0; m < 4; ++m) _Pragma("unroll") for (int n = 0; n < 2; ++n) _Pragma("unroll") for (int k = 0; k < 2; ++k) \
        acc[ai][bj][m][n] = __builtin_amdgcn_mfma_f32_16x16x32_bf16(Bt[n][k], At[m][k], acc[ai][bj][m][n], 0, 0, 0); __builtin_amdgcn_s_setprio(0); } while (0)
#define PG8_WAIT_V(n) asm volatile("s_waitcnt vmcnt(" #n ")" ::: "memory")
#define PG8_WAIT_L(n) asm volatile("s_waitcnt lgkmcnt(" #n ")" ::: "memory")
#define PG8_BAR __builtin_amdgcn_s_barrier()
#define PG8_SCHED __builtin_amdgcn_sched_barrier(0)
    Unit cur, nxt; int ui = 0;
    if (!S.next(0, cur)) return;
    f32x4 acc[2][2][4][2];
#pragma unroll
    for (int a = 0; a < 2; ++a)
#pragma unroll
        for (int b = 0; b < 2; ++b)
#pragma unroll
            for (int m = 0; m < 4; ++m)
#pragma unroll
                for (int n = 0; n < 2; ++n) acc[a][b][m][n] = (f32x4){0.f, 0.f, 0.f, 0.f};
    bf16x8 At[4][2], B0[2][2], B1[2][2];
    const char* cA = (const char*)g.A + (size_t)cur.pm * tstep; const char* cB = (const char*)g.Bt + (size_t)cur.pn * tstep;
    S.a_ready(cur);
    if constexpr (SP2) {
        PG8_STAGE(PG8_SB(0, 0), cB, voffB); PG8_STAGE(PG8_SB(0, 1), cB + hstep, voffB); PG8_STAGE(PG8_SA(0, 0), cA, voffA); PG8_STAGE(PG8_SA(0, 1), cA + hstep, voffA);
        if (wr == 1) PG8_BAR;
        PG8_WAIT_V(2); PG8_BAR;
        PG8_STAGE(PG8_SB(1, 0), cB + kstep, voffB); PG8_STAGE(PG8_SA(1, 0), cA + kstep, voffA); PG8_STAGE(PG8_SB(1, 1), cB + hstep + kstep, voffB);
        PG8_WAIT_V(6); PG8_BAR;
    } else {
        PG8_STAGE(PG8_SB(0, 0), cB, voffB); PG8_STAGE(PG8_SA(0, 0), cA, voffA); PG8_STAGE(PG8_SB(0, 1), cB + hstep, voffB); PG8_STAGE(PG8_SA(0, 1), cA + hstep, voffA);
        if (wr == 1) PG8_BAR;
        PG8_WAIT_V(4); PG8_BAR;
        PG8_STAGE(PG8_SB(1, 0), cB + kstep, voffB); PG8_STAGE(PG8_SA(1, 0), cA + kstep, voffA); PG8_STAGE(PG8_SB(1, 1), cB + hstep + kstep, voffB);
        PG8_WAIT_V(6); PG8_BAR;
    }
    for (;;) {
        const bool has_next = S.next(ui + 1, nxt);
        const char* nA = has_next ? (const char*)g.A + (size_t)nxt.pm * tstep : cA; const char* nB = has_next ? (const char*)g.Bt + (size_t)nxt.pn * tstep : cB;
        for (int t = 0; t < nt; t += 2) {
            const bool last = (t == nt - 2);
            const char* a1 = cA + (size_t)(t + 1) * kstep;
            const char* a2 = last ? nA : cA + (size_t)(t + 2) * kstep; const char* b2 = last ? nB : cB + (size_t)(t + 2) * kstep;
            const char* a3 = a2 + kstep; const char* b3 = b2 + kstep;
            if (last && has_next) S.a_ready(nxt);
            if constexpr (SP2) {
            PG8_LDB(B0, 0, 0); PG8_LDB(B1, 0, 1); PG8_SCHED; PG8_LDA(At, 0, 0); PG8_STAGE(PG8_SA(1, 1), a1 + hstep, voffA);
            PG8_WAIT_V(8); PG8_WAIT_L(0); PG8_BAR; PG8_MMA(0, 0, At, B0); PG8_MMA(0, 1, At, B1); PG8_BAR; PG8_SCHED;
            PG8_LDA(At, 0, 1); PG8_STAGE(PG8_SB(0, 0), b2, voffB); PG8_STAGE(PG8_SB(0, 1), b2 + hstep, voffB); PG8_STAGE(PG8_SA(0, 0), a2, voffA);
            PG8_WAIT_V(8); PG8_WAIT_L(0); PG8_BAR; PG8_MMA(1, 0, At, B0); PG8_MMA(1, 1, At, B1); PG8_BAR; PG8_SCHED;
            PG8_LDB(B0, 1, 0); PG8_LDB(B1, 1, 1); PG8_SCHED; PG8_LDA(At, 1, 0); PG8_STAGE(PG8_SA(0, 1), a2 + hstep, voffA);
            PG8_WAIT_V(8); PG8_WAIT_L(0); PG8_BAR; PG8_MMA(0, 0, At, B0); PG8_MMA(0, 1, At, B1); PG8_BAR; PG8_SCHED;
            PG8_LDA(At, 1, 1); PG8_STAGE(PG8_SB(1, 0), b3, voffB); PG8_STAGE(PG8_SB(1, 1), b3 + hstep, voffB); PG8_STAGE(PG8_SA(1, 0), a3, voffA);
            PG8_WAIT_V(8); PG8_WAIT_L(0); PG8_BAR; PG8_MMA(1, 0, At, B0); PG8_MMA(1, 1, At, B1); PG8_BAR; PG8_SCHED;
            } else {
            PG8_LDB(B0, 0, 0); PG8_SCHED; PG8_LDA(At, 0, 0); PG8_STAGE(PG8_SA(1, 1), a1 + hstep, voffA);
            PG8_WAIT_L(8); PG8_BAR; PG8_WAIT_L(0); PG8_MMA(0, 0, At, B0); PG8_BAR; PG8_SCHED;
            PG8_LDB(B1, 0, 1); PG8_STAGE(PG8_SB(0, 0), b2, voffB);
            PG8_BAR; PG8_WAIT_L(0); PG8_MMA(0, 1, At, B1); PG8_BAR;
            PG8_LDA(At, 0, 1); PG8_STAGE(PG8_SA(0, 0), a2, voffA);
            PG8_BAR; PG8_WAIT_L(0); PG8_MMA(1, 0, At, B0); PG8_BAR; PG8_SCHED;
            PG8_STAGE(PG8_SB(0, 1), b2 + hstep, voffB);
            PG8_WAIT_V(6); PG8_BAR; PG8_MMA(1, 1, At, B1); PG8_BAR;
            PG8_LDB(B0, 1, 0); PG8_SCHED; PG8_LDA(At, 1, 0); PG8_STAGE(PG8_SA(0, 1), a2 + hstep, voffA);
            PG8_WAIT_L(8); PG8_BAR; PG8_WAIT_L(0); PG8_MMA(0, 0, At, B0); PG8_BAR; PG8_SCHED;
            PG8_LDB(B1, 1, 1); PG8_STAGE(PG8_SB(1, 0), b3, voffB);
            PG8_BAR; PG8_WAIT_L(0); PG8_MMA(0, 1, At, B1); PG8_BAR;
            PG8_LDA(At, 1, 1); PG8_STAGE(PG8_SA(1, 0), a3, voffA);
            PG8_BAR; PG8_WAIT_L(0); PG8_MMA(1, 0, At, B0); PG8_BAR; PG8_SCHED;
            PG8_STAGE(PG8_SB(1, 1), b3 + hstep, voffB);
            PG8_WAIT_V(6); PG8_BAR; PG8_MMA(1, 1, At, B1); PG8_BAR;
            }
        }
        if constexpr (ALIGN_EPI) { if (wr == 0) PG8_BAR; }
        if constexpr (!Epi::AFTER_DRAIN) { E(acc, cur, wr, wc, fr, fq); S.done(cur); }
        if (!has_next) break;
#pragma unroll
        for (int a = 0; a < 2; ++a)
#pragma unroll
            for (int b = 0; b < 2; ++b)
#pragma unroll
                for (int m = 0; m < 4; ++m)
#pragma unroll
                    for (int n = 0; n < 2; ++n) acc[a][b][m][n] = (f32x4){0.f, 0.f, 0.f, 0.f};
        cur = nxt; cA = nA; cB = nB; ++ui;
        if constexpr (ALIGN_EPI) { if (wr == 1) PG8_BAR; }
    }
    PG8_WAIT_V(0);
    if constexpr (!ALIGN_EPI) { if (wr == 0) PG8_BAR; }
    PG8_BAR;
    if constexpr (Epi::AFTER_DRAIN) { E.fused(acc, cur, wr, wc, fr, fq, lds, wid, lane); S.done(cur); }
#undef PG8_SA
#undef PG8_SB
#undef PG8_STAGE
#undef PG8_LDA
#undef PG8_LDB
#undef PG8_MMA
#undef PG8_WAIT_V
#undef PG8_WAIT_L
#undef PG8_BAR
#undef PG8_SCHED
}
}
#define LAS __attribute__((address_space(3)))
#define DI __device__ __forceinline__
typedef unsigned short bf16;
typedef short bf16x8 __attribute__((ext_vector_type(8)));
typedef float f32x4 __attribute__((ext_vector_type(4)));
typedef float f32x2 __attribute__((ext_vector_type(2)));
typedef unsigned u32x4 __attribute__((ext_vector_type(4)));
typedef unsigned u32x2 __attribute__((ext_vector_type(2)));
typedef __bf16 bf2_t __attribute__((ext_vector_type(2)));
#define MFMA16(a, b, c) __builtin_amdgcn_mfma_f32_16x16x32_bf16((a), (b), (c), 0, 0, 0)
DI unsigned pk2(float lo, float hi) { f32x2 v = {lo, hi}; return __builtin_bit_cast(unsigned, __builtin_convertvector(v, bf2_t)); }
DI u32x2 pk4(f32x4 v) { u32x2 r; r.x = pk2(v[0], v[1]); r.y = pk2(v[2], v[3]); return r; }
DI float bf2f(bf16 h) { return __uint_as_float((unsigned)h << 16); }
DI float bflo(unsigned u) { return __uint_as_float(u << 16); }
DI float bfhi(unsigned u) { return __uint_as_float(u & 0xffff0000u); }
DI float wave_sum(float v) {
#pragma unroll
    for (int o = 1; o < 64; o <<= 1) v += __shfl_xor(v, o);
    return v;
}
DI float siluf(float y) { return y * __builtin_amdgcn_rcpf(1.f + __expf(-y)); }

constexpr int D = 1024, SEQ = 8192, MP = 16384, MS = 128, MR = MP + MS, MPAD = 16640, NIN = 2816, INW = 2824, FF = 4096;
constexpr float EPS = 1e-6f;
constexpr size_t MiB = 1u << 20;
constexpr size_t WS_LD = 0, WS_AB = 65536;
constexpr size_t WS_WIN = 1 * MiB, WS_WOUT = 7 * MiB, WS_WUP = 9 * MiB, WS_WDN = 17 * MiB;
constexpr size_t WS_XN = 25 * MiB, WS_QT = 25 * MiB, WS_OB = 41 * MiB, WS_MIX = 58 * MiB;
constexpr size_t WS_QA = 91 * MiB, WS_KV = 107 * MiB + 512 * 1024, WS_QG = 116 * MiB, WS_SG = 116 * MiB, WS_Z = 165 * MiB, WS_MP = 182 * MiB, WS_BST = 214 * MiB;
constexpr size_t WS_T1 = 91 * MiB, WS_H = 91 * MiB, WS_T2 = 25 * MiB, WS_END = 256 * MiB;
constexpr size_t O_Y = 0, O_PSC = 16908288, O_PCK = 16917504, O_PCV = 16950272, O_PSG = 16983040, O_SSC = 17114112, O_SCK = 17703936, O_SCV = 19801088, O_SSG = 21898240;
constexpr int LDS_CTL = 147456, LDS_XB = 147456 + 64, LDS_BYTES = 147456 + 64 + 8192;
constexpr size_t WS_BAR = 32768;

struct Params { const float* in[19]; float* out; unsigned char* ws; int use_cg, pad; };

DI void p0_transpose_item(const float* W, int ldw, int N, int K, bf16* WT, LAS float* scr, int item, int lane) {
    const int nblk = N / 32, kb = item / nblk, nb = item % nblk, k0 = 64 * kb, n0 = 32 * nb;
#pragma unroll 8
    for (int i = 0; i < 32; ++i) { const int kk = 2 * i + (lane >> 5); scr[kk * 33 + (lane & 31)] = W[(size_t)(k0 + kk) * ldw + n0 + (lane & 31)]; }
    asm volatile("s_waitcnt lgkmcnt(0)" ::: "memory");
    const int c = lane & 7;
#pragma unroll
    for (int j = 0; j < 4; ++j) { const int n = (lane >> 3) + 8 * j; const LAS float* s = scr + (8 * c) * 33 + n;
        u32x4 o; o.x = pk2(s[0 * 33], s[1 * 33]); o.y = pk2(s[2 * 33], s[3 * 33]); o.z = pk2(s[4 * 33], s[5 * 33]); o.w = pk2(s[6 * 33], s[7 * 33]);
        *(u32x4*)(WT + (size_t)(n0 + n) * K + k0 + 8 * c) = o; }
    asm volatile("s_waitcnt lgkmcnt(0)" ::: "memory");
}
DI void p0_prologue(const Params& p, LAS unsigned char* lds, int gw, int NGW, int wid, int lane) {
    asm volatile("" : "+v"(lane));
    LAS float* scr = (LAS float*)(lds + wid * 16384);
    unsigned char* ws = p.ws;
    constexpr int I_IN = (D / 64) * (NIN / 32);
    for (int it = gw; it < I_IN; it += NGW) p0_transpose_item(p.in[7], INW, NIN, D, (bf16*)(ws + WS_WIN), scr, it, lane);
    f32x4 wab[4][4][2];
    const float* win = p.in[7];
#pragma unroll
    for (int j = 0; j < 4; ++j)
#pragma unroll
        for (int e = 0; e < 4; ++e) { const float* wp = win + (size_t)(4 * lane + 256 * j + e) * INW + NIN; wab[j][e][0] = *(const f32x4*)wp; wab[j][e][1] = *(const f32x4*)(wp + 4); }
    f32x4 gv[4];
#pragma unroll
    for (int j = 0; j < 4; ++j) gv[j] = *(const f32x4*)(p.in[6] + 4 * lane + 256 * j);
    bf16* XN = (bf16*)(ws + WS_XN); float* AB = (float*)(ws + WS_AB);
    f32x4 nx[4];
    { const int m0 = gw < MR ? gw : 0; const float* xr0 = m0 < MP ? p.in[0] + (size_t)m0 * D : p.in[1] + (size_t)(m0 - MP) * D;
#pragma unroll
      for (int j = 0; j < 4; ++j) nx[j] = *(const f32x4*)(xr0 + 4 * lane + 256 * j); }
    for (int m = gw; m < MR; m += NGW) {
        f32x4 v[4]; float s = 0.f;
#pragma unroll
        for (int j = 0; j < 4; ++j) { v[j] = nx[j]; s += (v[j][0] * v[j][0] + v[j][1] * v[j][1]) + (v[j][2] * v[j][2] + v[j][3] * v[j][3]); }
        { const int mn = (m + NGW < MR) ? m + NGW : m; const float* xrn = mn < MP ? p.in[0] + (size_t)mn * D : p.in[1] + (size_t)(mn - MP) * D;
#pragma unroll
          for (int j = 0; j < 4; ++j) nx[j] = *(const f32x4*)(xrn + 4 * lane + 256 * j); }
        const float rstd = 1.f / sqrtf(wave_sum(s) * (1.f / D) + EPS);
        f32x4 a0 = {0.f, 0.f, 0.f, 0.f}, a1 = {0.f, 0.f, 0.f, 0.f};
#pragma unroll
        for (int j = 0; j < 4; ++j) { v[j] = v[j] * rstd * gv[j];
#pragma unroll
            for (int e = 0; e < 4; ++e) { a0 += wab[j][e][0] * v[j][e]; a1 += wab[j][e][1] * v[j][e]; }
            *(u32x2*)(XN + (size_t)m * D + 4 * lane + 256 * j) = pk4(v[j]); }
#pragma unroll
        for (int e = 0; e < 4; ++e) { a0[e] = wave_sum(a0[e]); a1[e] = wave_sum(a1[e]); }
        if (lane == 0) { *(f32x4*)(AB + (size_t)m * 8) = a0; *(f32x4*)(AB + (size_t)m * 8 + 4) = a1; }
    }
}

DI void late_transposes(const Params& p, LAS unsigned char* lds, int gw, int NGW, int wid, int lane) {
    asm volatile("" : "+v"(lane));
    LAS float* scr = (LAS float*)(lds + wid * 16384);
    unsigned char* ws = p.ws;
    constexpr int I_O = (D / 64) * (D / 32), I_U = (D / 64) * (FF / 32), I_D = (FF / 64) * (D / 32);
    for (int it = gw; it < I_O + I_U + I_D; it += NGW) {
        int r = it;
        if (r < I_O) { p0_transpose_item(p.in[13], D, D, D, (bf16*)(ws + WS_WOUT), scr, r, lane); continue; } r -= I_O;
        if (r < I_U) { p0_transpose_item(p.in[16], FF, FF, D, (bf16*)(ws + WS_WUP), scr, r, lane); continue; } r -= I_U;
        p0_transpose_item(p.in[17], D, D, FF, (bf16*)(ws + WS_WDN), scr, r, lane);
    }
}

DI bf16x8 ldfrag(const LAS bf16* base, int pitch, int r0, int k0, int fr, int fq) { return *(const LAS bf16x8*)(base + (r0 + fr) * pitch + k0 + 8 * fq); }

DI void gdn_prep_unit(const Params& p, LAS unsigned char* lds, int unit, int tid, int wid, int lane) {
    asm volatile("" : "+v"(tid), "+v"(lane));
    const int c = unit >> 7, n = unit & 127, b = c >> 2, h = c & 3;
    const int rowbase = b * SEQ + n * 64;
    const int fr = lane & 15, fq = lane >> 4;
    unsigned char* ws = p.ws;
    LAS bf16* q_rm = (LAS bf16*)(lds);
    LAS bf16* k_rm = (LAS bf16*)(lds + 17408);
    LAS float* Amat = (LAS float*)(lds + 34816);
    LAS bf16* UT = (LAS bf16*)(lds + 17408);
    LAS bf16* XT = (LAS bf16*)(lds + 54272);
    LAS bf16* kdT = (LAS bf16*)(lds + 91136);
    LAS bf16* Tinv = (LAS bf16*)(lds + 109568);
    LAS bf16* qk = (LAS bf16*)(lds + 118784);
    LAS float* sG = (LAS float*)(lds + 128000);
    LAS float* sBeta = sG + 64; LAS float* sEG = sG + 128; LAS float* sEKD = sG + 192; LAS float* sRS = sG + 256;
    LAS float* part = Amat;
    LAS bf16* T11T = (LAS bf16*)(lds + 130048); LAS bf16* A21b = (LAS bf16*)(lds + 132608); LAS bf16* PT = (LAS bf16*)(lds + 135168);
    const bf16* QG = (const bf16*)(ws + WS_QG);
    const float* AB = (const float*)(ws + WS_AB);
    if (wid == 7) {
        const float a = AB[(size_t)(rowbase + lane) * 8 + h], bb = AB[(size_t)(rowbase + lane) * 8 + 4 + h];
        const float xs = a + p.in[11][h];
        const float sp = fmaxf(xs, 0.f) + log1pf(__expf(-fabsf(xs)));
        const float g = -__expf(p.in[10][h]) * sp;
        float G = g;
#pragma unroll
        for (int o = 1; o < 64; o <<= 1) { const float t = __int_as_float(__builtin_amdgcn_ds_bpermute(((lane - o) & 63) << 2, __float_as_int(G))); if (lane >= o) G += t; }
        const float Gl = __int_as_float(__builtin_amdgcn_readlane(__float_as_int(G), 63));
        sG[lane] = G; sBeta[lane] = 1.f / (1.f + __expf(-bb)); sEG[lane] = __expf(G); sEKD[lane] = __expf(Gl - G);
        if (lane == 63) ((float*)(ws + WS_LD))[unit] = __expf(G);
    }
    float val[8][8];
    const int cgp = tid >> 3, tr = tid & 7, prt = cgp >> 4, d0 = (cgp & 15) * 8, t0 = tr * 8;
    if (tid < 384) {
        const int col = prt * 512 + h * 128 + d0;
        float w[4][8];
#pragma unroll
        for (int i = 0; i < 4; ++i) { const f32x4 w0 = *(const f32x4*)(p.in[9] + i * 1536 + col), w1 = *(const f32x4*)(p.in[9] + i * 1536 + col + 4);
#pragma unroll
            for (int e = 0; e < 4; ++e) { w[i][e] = w0[e]; w[i][4 + e] = w1[e]; } }
#pragma unroll
        for (int tt = 0; tt < 8; ++tt)
#pragma unroll
            for (int e = 0; e < 8; ++e) val[tt][e] = 0.f;
#pragma unroll
        for (int r = 0; r < 11; ++r) {
            const int tl = n * 64 + t0 + r - 3;
            u32x4 xv = {0u, 0u, 0u, 0u};
            if (tl >= 0) xv = *(const u32x4*)(QG + (size_t)(b * SEQ + tl) * 1536 + col);
            float x[8] = {bflo(xv.x), bfhi(xv.x), bflo(xv.y), bfhi(xv.y), bflo(xv.z), bfhi(xv.z), bflo(xv.w), bfhi(xv.w)};
#pragma unroll
            for (int i = 0; i < 4; ++i) { const int tt = r - i;
                if (tt >= 0 && tt < 8) {
#pragma unroll
                    for (int e = 0; e < 8; ++e) val[tt][e] += w[i][e] * x[e]; } }
        }
#pragma unroll
        for (int tt = 0; tt < 8; ++tt) { float s = 0.f;
#pragma unroll
            for (int e = 0; e < 8; ++e) { val[tt][e] = siluf(val[tt][e]); s += val[tt][e] * val[tt][e]; }
            if (prt < 2) part[(prt * 64 + t0 + tt) * 16 + (cgp & 15)] = s; }
    }
    __syncthreads();
    if (tid < 128) { float s = 0.f;
#pragma unroll
        for (int i = 0; i < 16; ++i) s += part[tid * 16 + ((i + tid) & 15)];
        sRS[tid] = (tid < 64 ? 0.08838834764831845f : 1.f) / sqrtf(s + EPS); }
    __syncthreads();
    if (tid < 384) {
        if (prt == 0) {
#pragma unroll
            for (int tt = 0; tt < 8; ++tt) { const float r = sRS[t0 + tt]; u32x4 o; o.x = pk2(val[tt][0] * r, val[tt][1] * r); o.y = pk2(val[tt][2] * r, val[tt][3] * r); o.z = pk2(val[tt][4] * r, val[tt][5] * r); o.w = pk2(val[tt][6] * r, val[tt][7] * r);
                *(LAS u32x4*)(q_rm + (t0 + tt) * 136 + d0) = o; }
        } else if (prt == 1) {
            float be[8], kd[8];
#pragma unroll
            for (int tt = 0; tt < 8; ++tt) { const float r = sRS[64 + t0 + tt]; be[tt] = sBeta[t0 + tt] * sEG[t0 + tt]; kd[tt] = sEKD[t0 + tt];
#pragma unroll
                for (int e = 0; e < 8; ++e) val[tt][e] *= r;
                u32x4 o; o.x = pk2(val[tt][0], val[tt][1]); o.y = pk2(val[tt][2], val[tt][3]); o.z = pk2(val[tt][4], val[tt][5]); o.w = pk2(val[tt][6], val[tt][7]);
                *(LAS u32x4*)(k_rm + (t0 + tt) * 136 + d0) = o; }
#pragma unroll
            for (int e = 0; e < 8; ++e) { u32x4 o, o2;
                o.x = pk2(val[0][e] * be[0], val[1][e] * be[1]); o.y = pk2(val[2][e] * be[2], val[3][e] * be[3]); o.z = pk2(val[4][e] * be[4], val[5][e] * be[5]); o.w = pk2(val[6][e] * be[6], val[7][e] * be[7]);
                o2.x = pk2(val[0][e] * kd[0], val[1][e] * kd[1]); o2.y = pk2(val[2][e] * kd[2], val[3][e] * kd[3]); o2.z = pk2(val[4][e] * kd[4], val[5][e] * kd[5]); o2.w = pk2(val[6][e] * kd[6], val[7][e] * kd[7]);
                *(LAS u32x4*)(XT + (128 + d0 + e) * 72 + t0) = o; *(LAS u32x4*)(kdT + (d0 + e) * 72 + t0) = o2; }
        } else {
            float be[8];
#pragma unroll
            for (int tt = 0; tt < 8; ++tt) be[tt] = sBeta[t0 + tt];
#pragma unroll
            for (int e = 0; e < 8; ++e) { u32x4 o;
                o.x = pk2(val[0][e] * be[0], val[1][e] * be[1]); o.y = pk2(val[2][e] * be[2], val[3][e] * be[3]); o.z = pk2(val[4][e] * be[4], val[5][e] * be[5]); o.w = pk2(val[6][e] * be[6], val[7][e] * be[7]);
                *(LAS u32x4*)(XT + (d0 + e) * 72 + t0) = o; }
        }
    }
    __syncthreads();
#pragma unroll
    for (int q = 0; q < 2; ++q) { const int idx = wid + 8 * q, it = idx >> 2, jt = idx & 3;
        if (jt <= it) { f32x4 acc = {0.f, 0.f, 0.f, 0.f};
#pragma unroll
            for (int s = 0; s < 4; ++s) acc = MFMA16(ldfrag(k_rm, 136, it * 16, 32 * s, fr, fq), ldfrag(k_rm, 136, jt * 16, 32 * s, fr, fq), acc);
            const int j = jt * 16 + fr; const float Gj = sG[j];
#pragma unroll
            for (int i2 = 0; i2 < 4; ++i2) { const int i = it * 16 + 4 * fq + i2; const float av = sBeta[i] * acc[i2] * __expf(fminf(sG[i] - Gj, 0.f)); Amat[i * 68 + j] = av;
                if (it >= 2 && jt < 2) A21b[(i - 32) * 40 + j] = (bf16)(pk2(av, 0.f) & 0xffffu); } } }
    __syncthreads();
    if (wid < 2) {
#ifndef NOINV
        const int o = 32 * wid, cl = lane & 31;
        float T[32];
#pragma unroll
        for (int i = 0; i < 32; ++i) { float a = (i == cl) ? 1.f : 0.f;
#pragma unroll
            for (int jg = 0; jg < (i + 3) / 4; ++jg) { const f32x4 av = *(const LAS f32x4*)(Amat + (o + i) * 68 + o + 4 * jg);
#pragma unroll
                for (int e = 0; e < 4; ++e) if (4 * jg + e < i) a -= av[e] * T[4 * jg + e]; }
            T[i] = a; }
        if (lane < 32) {
#pragma unroll
            for (int i = 0; i < 32; i += 2) { const unsigned pk = pk2(T[i], T[i + 1]); Tinv[(o + i) * 72 + o + cl] = (bf16)(pk & 0xffffu); Tinv[(o + i + 1) * 72 + o + cl] = (bf16)(pk >> 16); }
            if (wid == 0) {
#pragma unroll
                for (int i = 0; i < 32; i += 8) { u32x4 w; w.x = pk2(T[i], T[i + 1]); w.y = pk2(T[i + 2], T[i + 3]); w.z = pk2(T[i + 4], T[i + 5]); w.w = pk2(T[i + 6], T[i + 7]); *(LAS u32x4*)(T11T + cl * 40 + i) = w; } }
        } else if (wid == 0) {
#pragma unroll
            for (int i = 0; i < 32; ++i) Tinv[i * 72 + 32 + cl] = 0;
        }
#endif
    } else {
        for (int idx = wid - 2; idx < 16; idx += 6) { const int it = idx >> 2, jt = idx & 3;
            f32x4 acc = {0.f, 0.f, 0.f, 0.f};
            if (jt <= it) {
#pragma unroll
                for (int s = 0; s < 4; ++s) acc = MFMA16(ldfrag(k_rm, 136, jt * 16, 32 * s, fr, fq), ldfrag(q_rm, 136, it * 16, 32 * s, fr, fq), acc);
                const int i = it * 16 + fr; const float Gi = sG[i];
#pragma unroll
                for (int i2 = 0; i2 < 4; ++i2) { const int j = jt * 16 + 4 * fq + i2; acc[i2] = (i >= j) ? acc[i2] * __expf(fminf(Gi - sG[j], 0.f)) : 0.f; } }
            *(LAS u32x2*)(qk + (it * 16 + fr) * 72 + jt * 16 + 4 * fq) = pk4(acc); }
    }
    __syncthreads();
    if (wid == 0) {
#pragma unroll
        for (int jt = 0; jt < 2; ++jt) { const bf16x8 yv = *(const LAS bf16x8*)(T11T + (jt * 16 + fr) * 40 + 8 * fq);
#pragma unroll
            for (int it = 0; it < 2; ++it) { f32x4 a = {0.f, 0.f, 0.f, 0.f}; a = MFMA16(*(const LAS bf16x8*)(A21b + (it * 16 + fr) * 40 + 8 * fq), yv, a);
                *(LAS u32x2*)(PT + (jt * 16 + fr) * 40 + it * 16 + 4 * fq) = pk4(a); } }
        asm volatile("s_waitcnt lgkmcnt(0)" ::: "memory");
#pragma unroll
        for (int jt = 0; jt < 2; ++jt) { const bf16x8 yv = *(const LAS bf16x8*)(PT + (jt * 16 + fr) * 40 + 8 * fq);
#pragma unroll
            for (int it = 0; it < 2; ++it) { f32x4 a = {0.f, 0.f, 0.f, 0.f}; a = MFMA16(*(const LAS bf16x8*)(Tinv + (32 + it * 16 + fr) * 72 + 32 + 8 * fq), yv, a);
                const u32x2 w = pk4(-a); const int j = jt * 16 + fr, i0 = 32 + it * 16 + 4 * fq;
                Tinv[i0 * 72 + j] = (bf16)(w.x & 0xffffu); Tinv[(i0 + 1) * 72 + j] = (bf16)(w.x >> 16); Tinv[(i0 + 2) * 72 + j] = (bf16)(w.y & 0xffffu); Tinv[(i0 + 3) * 72 + j] = (bf16)(w.y >> 16); } }
    }
    __syncthreads();
    { int t2 = threadIdx.x; asm volatile("" : "+v"(t2)); lane = t2 & 63; }
    const int fr3 = lane & 15, fq3 = lane >> 4;
#pragma unroll
    for (int q = 0; q < 2; ++q) { const int ft = 2 * wid + q;
        const bf16x8 y0 = ldfrag(XT, 72, ft * 16, 0, fr3, fq3), y1 = ldfrag(XT, 72, ft * 16, 32, fr3, fq3);
        f32x4 acc[4];
#pragma unroll
        for (int ct = 0; ct < 4; ++ct) { acc[ct] = (f32x4){0.f, 0.f, 0.f, 0.f}; acc[ct] = MFMA16(ldfrag(Tinv, 72, ct * 16, 0, fr3, fq3), y0, acc[ct]); acc[ct] = MFMA16(ldfrag(Tinv, 72, ct * 16, 32, fr3, fq3), y1, acc[ct]); }
#pragma unroll
        for (int ct = 0; ct < 4; ++ct) *(LAS u32x2*)(UT + (ft * 16 + fr3) * 72 + ct * 16 + 4 * fq3) = pk4(acc[ct]); }
    __syncthreads();
    {
        bf16* MPo = (bf16*)(ws + WS_MP) + (size_t)unit * 16384;
        bf16* BSo = (bf16*)(ws + WS_BST) + (size_t)unit * 16384;
        bf16* QTo = (bf16*)(ws + WS_QT) + (size_t)unit * 8192;
        bf16* OBo = (bf16*)(ws + WS_OB) + (size_t)unit * 8192;
        const bf16x8 w0 = ldfrag(UT, 72, 128 + wid * 16, 0, fr3, fq3), w1 = ldfrag(UT, 72, 128 + wid * 16, 32, fr3, fq3);
        const bf16x8 kd0 = ldfrag(kdT, 72, wid * 16, 0, fr3, fq3), kd1 = ldfrag(kdT, 72, wid * 16, 32, fr3, fq3);
        const bf16x8 u0 = ldfrag(UT, 72, wid * 16, 0, fr3, fq3), u1 = ldfrag(UT, 72, wid * 16, 32, fr3, fq3);
#pragma unroll
        for (int dt = 0; dt < 8; ++dt) {
            f32x4 a = {0.f, 0.f, 0.f, 0.f};
            a = MFMA16(w0, ldfrag(kdT, 72, dt * 16, 0, fr3, fq3), a); a = MFMA16(w1, ldfrag(kdT, 72, dt * 16, 32, fr3, fq3), a);
            const int s = wid >> 1, jb = (wid & 1) * 4, blk = dt * 4 + s;
            *(u32x2*)(MPo + ((size_t)(blk * 64 + lane) * 8 + jb)) = pk4(-a);
            f32x4 bacc = {0.f, 0.f, 0.f, 0.f};
            bacc = MFMA16(kd0, ldfrag(UT, 72, dt * 16, 0, fr3, fq3), bacc); bacc = MFMA16(kd1, ldfrag(UT, 72, dt * 16, 32, fr3, fq3), bacc);
            *(u32x2*)(BSo + ((size_t)((dt * 8 + wid) * 64 + lane) * 4)) = pk4(bacc);
        }
#pragma unroll
        for (int ct = 0; ct < 4; ++ct) {
            const bf16x8 y0 = ldfrag(qk, 72, ct * 16, 0, fr3, fq3), y1 = ldfrag(qk, 72, ct * 16, 32, fr3, fq3);
            f32x4 a = {0.f, 0.f, 0.f, 0.f}; a = MFMA16(w0, y0, a); a = MFMA16(w1, y1, a);
            const int cc = ct * 16 + fr3, dd = wid * 16 + 4 * fq3; const float eg = sEG[cc];
            const u32x2 qv = *(const LAS u32x2*)(q_rm + cc * 136 + dd);
            f32x4 o; o[0] = bflo(qv.x) * eg - a[0]; o[1] = bfhi(qv.x) * eg - a[1]; o[2] = bflo(qv.y) * eg - a[2]; o[3] = bfhi(qv.y) * eg - a[3];
            *(u32x2*)(QTo + cc * 128 + dd) = pk4(o);
            f32x4 ob = {0.f, 0.f, 0.f, 0.f}; ob = MFMA16(u0, y0, ob); ob = MFMA16(u1, y1, ob);
            *(u32x2*)(OBo + cc * 128 + dd) = pk4(ob);
        }
    }
    __syncthreads();
}
DI void scan_issue(const char* MPc, const char* BSc, LAS unsigned char* lds, int n, int lw, int lane) {
    const int slot = n & 3;
#pragma unroll
    for (int q = 0; q < 9; ++q) { const int blk = lw * 9 + q;
        const char* src = blk < 32 ? MPc + (size_t)n * 32768 + blk * 1024 : BSc + (size_t)n * 32768 + (blk - 32) * 1024;
        __builtin_amdgcn_global_load_lds((const unsigned*)(src + lane * 16), (LAS unsigned*)(lds + slot * 36864 + blk * 1024), 16, 0, 0); }
}
constexpr int PFD = 64;
template <int PART> DI void scan_phase(const Params& p, LAS unsigned char* lds, int wg, int wid, int lane) {
    constexpr int N0 = PART * 64, N1 = N0 + 64;
    asm volatile("" : "+v"(lane));
    const int c = wg & 7, sl = wg >> 3, fr = lane & 15, fq = lane >> 4, e0 = sl * 16;
    unsigned char* ws = p.ws;
    const char* MPc = (const char*)(ws + WS_MP) + (size_t)c * 128 * 32768;
    const char* BSc = (const char*)(ws + WS_BST) + (size_t)c * 128 * 32768 + sl * 4096;
    bf16* SGc = (bf16*)p.out + (size_t)c * 128 * 16384;
    const float* LD = (const float*)(ws + WS_LD) + c * 128;
    const bool loader = (wid >= 1 && wid <= 4); const int lw = wid - 1;
    unsigned pfdummy = 0u;
    f32x4 acc[8];
#pragma unroll
    for (int t = 0; t < 8; ++t) acc[t] = (f32x4){0.f, 0.f, 0.f, 0.f};
    float ldv0 = 0.f;
    if (wid == 0) { ldv0 = LD[N0 + lane];
        if (PART == 1) {
#pragma unroll
            for (int t = 0; t < 8; ++t) acc[t] = *(const LAS f32x4*)(lds + LDS_XB + (t * 64 + lane) * 16); } }
    if (loader) { scan_issue(MPc, BSc, lds, N0, lw, lane); scan_issue(MPc, BSc, lds, N0 + 1, lw, lane); scan_issue(MPc, BSc, lds, N0 + 2, lw, lane); asm volatile("s_waitcnt vmcnt(18)" ::: "memory"); }
    __builtin_amdgcn_s_barrier(); asm volatile("" ::: "memory");
    for (int n = N0; n < N1; ++n) {
        if (loader) { if (n + 3 < N1) { scan_issue(MPc, BSc, lds, n + 3, lw, lane); asm volatile("s_waitcnt vmcnt(18)" ::: "memory"); } else { asm volatile("s_waitcnt vmcnt(0)" ::: "memory"); } }
        if (wid == 5 && n + PFD < N1) {
            const char* pm = MPc + (size_t)(n + PFD) * 32768 + lane * 128; const char* pb = BSc + (size_t)(n + PFD) * 32768 + (lane & 31) * 128;
            asm volatile("global_load_dword %0, %1, off\n\tglobal_load_dword %0, %2, off\n\tglobal_load_dword %0, %3, off\n\tglobal_load_dword %0, %4, off\n\tglobal_load_dword %0, %5, off" : "+v"(pfdummy) : "v"(pm), "v"(pm + 8192), "v"(pm + 16384), "v"(pm + 24576), "v"(pb) : "memory");
        }
        if (wid == 0) {
            const LAS unsigned char* slot = lds + (n & 3) * 36864;
            bf16x8 mf[8][4];
#pragma unroll
            for (int m = 0; m < 4; ++m)
#pragma unroll
                for (int s = 0; s < 4; ++s) mf[m][s] = *(const LAS bf16x8*)(slot + (m * 4 + s) * 1024 + lane * 16);
            __builtin_amdgcn_sched_barrier(0);
            const float ld = __int_as_float(__builtin_amdgcn_readlane(__float_as_int(ldv0), n & 63));
            u32x2 pk[8];
#pragma unroll
            for (int t = 0; t < 8; ++t) { pk[t] = pk4(acc[t]); *(u32x2*)(SGc + (size_t)n * 16384 + (e0 + fr) * 128 + 16 * t + 4 * fq) = pk[t]; }
            bf16x8 Sb[4];
#pragma unroll
            for (int s = 0; s < 4; ++s) { u32x4 v; v.x = pk[2 * s].x; v.y = pk[2 * s].y; v.z = pk[2 * s + 1].x; v.w = pk[2 * s + 1].y; Sb[s] = __builtin_bit_cast(bf16x8, v); }
#pragma unroll
            for (int t = 0; t < 8; ++t) { const u32x2 bb = *(const LAS u32x2*)(slot + 32768 + t * 512 + lane * 8);
                acc[t][0] = ld * acc[t][0] + bflo(bb.x); acc[t][1] = ld * acc[t][1] + bfhi(bb.x); acc[t][2] = ld * acc[t][2] + bflo(bb.y); acc[t][3] = ld * acc[t][3] + bfhi(bb.y); }
            __builtin_amdgcn_sched_barrier(0);
#pragma unroll
            for (int m = 4; m < 8; ++m)
#pragma unroll
                for (int s = 0; s < 4; ++s) mf[m][s] = *(const LAS bf16x8*)(slot + (m * 4 + s) * 1024 + lane * 16);
            __builtin_amdgcn_sched_barrier(0);
#pragma unroll
            for (int s = 0; s < 4; ++s)
#pragma unroll
                for (int m = 0; m < 4; ++m) acc[m] = MFMA16(mf[m][s], Sb[s], acc[m]);
            __builtin_amdgcn_sched_barrier(0);
#pragma unroll
            for (int s = 0; s < 4; ++s)
#pragma unroll
                for (int m = 4; m < 8; ++m) acc[m] = MFMA16(mf[m][s], Sb[s], acc[m]);
            asm volatile("s_waitcnt lgkmcnt(0)" ::: "memory");
        }
        __builtin_amdgcn_s_barrier(); asm volatile("" ::: "memory");
    }
    if (wid == 0 && PART == 0) {
#pragma unroll
        for (int t = 0; t < 8; ++t) *(LAS f32x4*)(lds + LDS_XB + (t * 64 + lane) * 16) = acc[t]; }
    if (wid == 0 && PART == 1) { float* So = p.out + O_PSG + (size_t)c * 16384;
#pragma unroll
        for (int t = 0; t < 8; ++t)
#pragma unroll
            for (int i = 0; i < 4; ++i) So[(16 * t + 4 * fq + i) * 128 + e0 + fr] = acc[t][i]; }
    asm volatile("s_waitcnt vmcnt(0)" : "+v"(pfdummy) :: "memory");
    __syncthreads();
}

DI void attn_unit(const Params& p, LAS unsigned char* lds, int unit, int tid, int wid, int lane) {
    asm volatile("" : "+v"(tid), "+v"(lane));
    const int kvh = unit & 1, nb = (unit >> 1) & 63, b = unit >> 7;
    const int fr = lane & 15, fq = lane >> 4;
    unsigned char* ws = p.ws;
    const bf16* QA = (const bf16*)(ws + WS_QA); const bf16* KV = (const bf16*)(ws + WS_KV); bf16* MIX = (bf16*)(ws + WS_MIX);
    LAS bf16* Ks = (LAS bf16*)lds;
    LAS bf16* Vt = (LAS bf16*)(lds + 36864);
    const int tok0 = b * SEQ + 128 * (nb - 1);
    for (int it = tid; it < 2048; it += 512) { const int key = it >> 3, ch = it & 7;
        u32x4 kv = {0u, 0u, 0u, 0u}, vv = {0u, 0u, 0u, 0u};
        if (nb > 0 || key >= 128) { const bf16* src = KV + (size_t)(tok0 + key) * 256 + kvh * 64 + ch * 8; kv = *(const u32x4*)src; vv = *(const u32x4*)(src + 128); }
        *(LAS u32x4*)(Ks + key * 72 + ch * 8) = kv;
        LAS bf16* vd = Vt + (ch * 8) * 280 + key;
        vd[0] = (bf16)(vv.x & 0xffffu); vd[280] = (bf16)(vv.x >> 16); vd[560] = (bf16)(vv.y & 0xffffu); vd[840] = (bf16)(vv.y >> 16);
        vd[1120] = (bf16)(vv.z & 0xffffu); vd[1400] = (bf16)(vv.z >> 16); vd[1680] = (bf16)(vv.w & 0xffffu); vd[1960] = (bf16)(vv.w >> 16); }
    for (int it = tid; it < 64 * 24; it += 512) Vt[(it / 24) * 280 + 256 + (it % 24)] = 0;
    __syncthreads();
    const int g = wid >> 1, h = kvh * 4 + g, qh = wid & 1;
    const float slope = exp2f(-(float)(h + 1)), sink = p.in[8][h];
    for (int qt = 0; qt < 4; ++qt) {
        const int q0 = 64 * qh + 16 * qt;
        const size_t qrow = (size_t)(b * SEQ + 128 * nb + q0 + fr);
        const bf16x8 qf0 = *(const bf16x8*)(QA + qrow * 512 + h * 64 + 8 * fq), qf1 = *(const bf16x8*)(QA + qrow * 512 + h * 64 + 32 + 8 * fq);
        f32x4 sc[10]; float mx = sink;
#pragma unroll
        for (int kt = 0; kt < 9; ++kt) { const int ks0 = q0 + 16 * kt;
            f32x4 a = {0.f, 0.f, 0.f, 0.f};
            a = MFMA16(ldfrag(Ks, 72, ks0, 0, fr, fq), qf0, a); a = MFMA16(ldfrag(Ks, 72, ks0, 32, fr, fq), qf1, a);
#pragma unroll
            for (int i = 0; i < 4; ++i) { const int si = ks0 + 4 * fq + i, dist = 128 + q0 + fr - si;
                const bool ok = (dist >= 0) && (dist <= 128) && (nb > 0 || si >= 128);
                a[i] = ok ? a[i] * 0.125f - slope * (float)dist : -INFINITY; mx = fmaxf(mx, a[i]); }
            sc[kt] = a; }
        mx = fmaxf(mx, __shfl_xor(mx, 16)); mx = fmaxf(mx, __shfl_xor(mx, 32));
        float sum = 0.f;
#pragma unroll
        for (int kt = 0; kt < 9; ++kt)
#pragma unroll
            for (int i = 0; i < 4; ++i) { const float e = __expf(sc[kt][i] - mx); sc[kt][i] = e; sum += e; }
        sc[9] = (f32x4){0.f, 0.f, 0.f, 0.f};
        sum += __shfl_xor(sum, 16); sum += __shfl_xor(sum, 32);
        const float inv = 1.f / (sum + __expf(sink - mx));
        f32x4 o[4];
#pragma unroll
        for (int dt = 0; dt < 4; ++dt) o[dt] = (f32x4){0.f, 0.f, 0.f, 0.f};
#pragma unroll
        for (int s2 = 0; s2 < 5; ++s2) { const u32x2 p0 = pk4(sc[2 * s2]), p1 = pk4(sc[2 * s2 + 1]);
            u32x4 pv; pv.x = p0.x; pv.y = p0.y; pv.z = p1.x; pv.w = p1.y; const bf16x8 pb = __builtin_bit_cast(bf16x8, pv);
#pragma unroll
            for (int dt = 0; dt < 4; ++dt) { const LAS bf16* vp = Vt + (dt * 16 + fr) * 280 + q0 + 32 * s2 + 4 * fq;
                const u32x2 va = *(const LAS u32x2*)vp, vb = *(const LAS u32x2*)(vp + 16);
                u32x4 vv; vv.x = va.x; vv.y = va.y; vv.z = vb.x; vv.w = vb.y;
                o[dt] = MFMA16(__builtin_bit_cast(bf16x8, vv), pb, o[dt]); } }
#pragma unroll
        for (int dt = 0; dt < 4; ++dt) *(u32x2*)(MIX + qrow * 1024 + h * 64 + dt * 16 + 4 * fq) = pk4(o[dt] * inv);
    }
    __syncthreads();
}

DI void gdn_out_pair(const Params& p, int pair, int wid, int lane) {
    asm volatile("" : "+v"(lane));
    const int unit = pair * 2 + (wid >> 2), ct = wid & 3;
    const int c = unit >> 7, n = unit & 127, b = c >> 2, h = c & 3, fr = lane & 15, fq = lane >> 4;
    unsigned char* ws = p.ws;
    const bf16* QTo = (const bf16*)(ws + WS_QT) + (size_t)unit * 8192;
    const bf16* OBo = (const bf16*)(ws + WS_OB) + (size_t)unit * 8192;
    const bf16* SGo = (const bf16*)p.out + (size_t)unit * 16384;
    const int tokc = ct * 16 + fr; const size_t row = (size_t)(b * SEQ + n * 64 + tokc);
    bf16x8 qf[4];
#pragma unroll
    for (int s = 0; s < 4; ++s) qf[s] = *(const bf16x8*)(QTo + tokc * 128 + 32 * s + 8 * fq);
    u32x2 obv[8], zv[8];
#pragma unroll
    for (int t = 0; t < 8; ++t) { obv[t] = *(const u32x2*)(OBo + tokc * 128 + 16 * t + 4 * fq); zv[t] = *(const u32x2*)((const bf16*)(ws + WS_Z) + row * 512 + h * 128 + 16 * t + 4 * fq); }
    bf16x8 sf[8][4];
#pragma unroll
    for (int t = 0; t < 8; ++t)
#pragma unroll
        for (int s = 0; s < 4; ++s) sf[t][s] = *(const bf16x8*)(SGo + (16 * t + fr) * 128 + 32 * s + 8 * fq);
    f32x4 gnv[8];
#pragma unroll
    for (int t = 0; t < 8; ++t) gnv[t] = *(const f32x4*)(p.in[12] + 16 * t + 4 * fq);
    f32x4 o[8]; float ss = 0.f;
#pragma unroll
    for (int t = 0; t < 8; ++t) {
        f32x4 a = {bflo(obv[t].x), bfhi(obv[t].x), bflo(obv[t].y), bfhi(obv[t].y)};
#pragma unroll
        for (int s = 0; s < 4; ++s) a = MFMA16(sf[t][s], qf[s], a);
        o[t] = a; ss += (a[0] * a[0] + a[1] * a[1]) + (a[2] * a[2] + a[3] * a[3]); }
    ss += __shfl_xor(ss, 16); ss += __shfl_xor(ss, 32);
    const float rstd = 1.f / sqrtf(ss * (1.f / 128.f) + EPS);
    bf16* MIX = (bf16*)(ws + WS_MIX);
#pragma unroll
    for (int t = 0; t < 8; ++t) { const int e = 16 * t + 4 * fq;
        const f32x4 gn = gnv[t];
        f32x4 y; y[0] = o[t][0] * rstd * gn[0] * siluf(bflo(zv[t].x)); y[1] = o[t][1] * rstd * gn[1] * siluf(bfhi(zv[t].x)); y[2] = o[t][2] * rstd * gn[2] * siluf(bflo(zv[t].y)); y[3] = o[t][3] * rstd * gn[3] * siluf(bfhi(zv[t].y));
        *(u32x2*)(MIX + row * 1024 + 512 + h * 128 + e) = pk4(y); }
}

DI void sample_gdn_unit(const Params& p, LAS unsigned char* lds, int unit, int tid, int wid, int lane) {
    asm volatile("" : "+v"(tid), "+v"(lane));
    const int b = unit >> 2, h = unit & 3; const size_t row = MP + b;
    unsigned char* ws = p.ws;
    LAS float* qs = (LAS float*)lds; LAS float* ks = qs + 128; LAS float* vs = qs + 256; LAS float* red = qs + 384; LAS float* red2 = qs + 896; LAS float* ssw = qs + 1408;
    const bf16* QG = (const bf16*)(ws + WS_QG); const float* AB = (const float*)(ws + WS_AB);
    const int e = tid & 127, dg = tid >> 7;
    const float* S0 = p.in[5] + ((size_t)(b * 4 + h) * 128 + dg * 32) * 128 + e;
    float S[32];
#pragma unroll
    for (int i = 0; i < 32; ++i) S[i] = S0[i * 128];
    const float a_ab = AB[row * 8 + h], b_ab = AB[row * 8 + 4 + h], dtb = p.in[11][h], alog = p.in[10][h];
    const float zraw = bf2f(((const bf16*)(ws + WS_Z))[row * 512 + h * 128 + e]), gnv = p.in[12][e];
    float val = 0.f; const int prt = tid >> 7, d = tid & 127;
    if (tid < 384) { const int col = prt * 512 + h * 128 + d; const float* cw = p.in[9]; const float* sc = p.in[2] + (size_t)b * 3 * 1536 + col;
        const float y = cw[col] * sc[0] + cw[1536 + col] * sc[1536] + cw[3072 + col] * sc[3072] + cw[4608 + col] * bf2f(QG[row * 1536 + col]);
        val = siluf(y); const float s = wave_sum(val * val); if (lane == 0) ssw[wid] = s; }
    __syncthreads();
    if (tid < 384) { if (prt == 0) qs[d] = val * 0.08838834764831845f / sqrtf(ssw[0] + ssw[1] + EPS); else if (prt == 1) ks[d] = val / sqrtf(ssw[2] + ssw[3] + EPS); else vs[d] = val; }
    __syncthreads();
    const float xs = a_ab + dtb;
    const float g = -__expf(alog) * (fmaxf(xs, 0.f) + log1pf(__expf(-fabsf(xs))));
    const float beta = 1.f / (1.f + __expf(-b_ab)), eg = __expf(g);
    float kvp = 0.f;
#pragma unroll
    for (int i = 0; i < 32; ++i) { S[i] *= eg; kvp += ks[dg * 32 + i] * S[i]; }
    red[dg * 128 + e] = kvp;
    __syncthreads();
    const float u = (vs[e] - (red[e] + red[128 + e] + red[256 + e] + red[384 + e])) * beta;
    float* So = p.out + O_SSG + ((size_t)(b * 4 + h) * 128 + dg * 32) * 128 + e; float op = 0.f;
#pragma unroll
    for (int i = 0; i < 32; ++i) { S[i] += ks[dg * 32 + i] * u; op += qs[dg * 32 + i] * S[i]; So[i * 128] = S[i]; }
    red2[dg * 128 + e] = op;
    __syncthreads();
    float o = 0.f;
    if (tid < 128) { o = red2[e] + red2[128 + e] + red2[256 + e] + red2[384 + e]; const float s = wave_sum(o * o); if (lane == 0) ssw[8 + wid] = s; }
    __syncthreads();
    if (tid < 128) { const float rstd = 1.f / sqrtf((ssw[8] + ssw[9]) * (1.f / 128.f) + EPS);
        const float y = o * rstd * gnv * siluf(zraw);
        ((bf16*)(ws + WS_MIX))[row * 1024 + 512 + h * 128 + e] = (bf16)(pk2(y, 0.f) & 0xffffu); }
    __syncthreads();
}
DI void sample_attn_unit(const Params& p, LAS unsigned char* lds, int b, int tid, int wid, int lane) {
    asm volatile("" : "+v"(tid), "+v"(lane));
    unsigned char* ws = p.ws; const size_t row = MP + b;
    const bf16* QA = (const bf16*)(ws + WS_QA); const bf16* KV = (const bf16*)(ws + WS_KV);
    LAS float* Kl = (LAS float*)lds;
    LAS float* Vl = (LAS float*)(lds + 2 * 128 * 68 * 4);
    const float* kc = p.in[3] + (size_t)b * 16384; const float* vc = p.in[4] + (size_t)b * 16384;
    float* ok = p.out + O_SCK + (size_t)b * 16384; float* ov = p.out + O_SCV + (size_t)b * 16384;
    f32x4 kreg[8], vreg[8];
#pragma unroll
    for (int q = 0; q < 8; ++q) { const int i4 = tid + 512 * q; kreg[q] = *(const f32x4*)(kc + 4 * i4); vreg[q] = *(const f32x4*)(vc + 4 * i4); }
#pragma unroll
    for (int q = 0; q < 8; ++q) { const int i4 = tid + 512 * q, key = i4 >> 5, kvh = (i4 >> 4) & 1, d4 = (i4 & 15) * 4;
        *(LAS f32x4*)(Kl + (kvh * 128 + key) * 68 + d4) = kreg[q]; *(LAS f32x4*)(Vl + (kvh * 128 + key) * 68 + d4) = vreg[q];
        if (key >= 1) { *(f32x4*)(ok + 4 * i4 - 128) = kreg[q]; *(f32x4*)(ov + 4 * i4 - 128) = vreg[q]; } }
    if (tid < 32) { const u32x2 kn = *(const u32x2*)(KV + row * 256 + 4 * tid), vn = *(const u32x2*)(KV + row * 256 + 128 + 4 * tid);
        *(f32x4*)(ok + 127 * 128 + 4 * tid) = (f32x4){bflo(kn.x), bfhi(kn.x), bflo(kn.y), bfhi(kn.y)}; *(f32x4*)(ov + 127 * 128 + 4 * tid) = (f32x4){bflo(vn.x), bfhi(vn.x), bflo(vn.y), bfhi(vn.y)}; }
    __syncthreads();
    const int h = wid, kvh = h >> 2;
    const float slope = exp2f(-(float)(h + 1)), sink = p.in[8][h];
    const LAS float* Kh = Kl + kvh * 128 * 68; const LAS float* Vh = Vl + kvh * 128 * 68;
    float s0 = 0.f, s1 = 0.f, s2 = 0.f;
#pragma unroll
    for (int c4 = 0; c4 < 16; ++c4) { const u32x2 qv = *(const u32x2*)(QA + row * 512 + h * 64 + 4 * c4);
        const float q0 = bflo(qv.x), q1 = bfhi(qv.x), q2 = bflo(qv.y), q3 = bfhi(qv.y);
        const f32x4 k0 = *(const LAS f32x4*)(Kh + lane * 68 + 4 * c4), k1 = *(const LAS f32x4*)(Kh + (lane + 64) * 68 + 4 * c4);
        const u32x2 kn = *(const u32x2*)(KV + row * 256 + kvh * 64 + 4 * c4);
        s0 += q0 * k0[0] + q1 * k0[1] + q2 * k0[2] + q3 * k0[3]; s1 += q0 * k1[0] + q1 * k1[1] + q2 * k1[2] + q3 * k1[3];
        s2 += q0 * bflo(kn.x) + q1 * bfhi(kn.x) + q2 * bflo(kn.y) + q3 * bfhi(kn.y); }
    s0 = s0 * 0.125f - slope * (float)(128 - lane); s1 = s1 * 0.125f - slope * (float)(64 - lane); s2 = s2 * 0.125f;
    float mx = fmaxf(fmaxf(s0, s1), fmaxf(s2, sink));
#pragma unroll
    for (int o = 1; o < 64; o <<= 1) mx = fmaxf(mx, __shfl_xor(mx, o));
    const float p0 = __expf(s0 - mx), p1 = __expf(s1 - mx), p2 = __expf(s2 - mx);
    const float inv = 1.f / (wave_sum(p0 + p1) + p2 + __expf(sink - mx));
    float o = p2 * bf2f(KV[row * 256 + 128 + kvh * 64 + lane]);
#pragma unroll
    for (int j = 0; j < 64; ++j) { o += __int_as_float(__builtin_amdgcn_readlane(__float_as_int(p0), j)) * Vh[j * 68 + lane] + __int_as_float(__builtin_amdgcn_readlane(__float_as_int(p1), j)) * Vh[(j + 64) * 68 + lane]; }
    ((bf16*)(ws + WS_MIX))[row * 1024 + h * 64 + lane] = (bf16)(pk2(o * inv, 0.f) & 0xffffu);
    __syncthreads();
}
DI void state_copies(const Params& p, int gtid, int nthr) {
    unsigned char* ws = p.ws; const bf16* QG = (const bf16*)(ws + WS_QG); const bf16* KV = (const bf16*)(ws + WS_KV);
    for (int idx = gtid; idx < 9216; idx += nthr) { const int b = idx / 4608, i = (idx % 4608) / 1536, ch = idx % 1536; p.out[O_PSC + idx] = bf2f(QG[(size_t)(b * SEQ + SEQ - 3 + i) * 1536 + ch]); }
    for (int idx = gtid; idx < 32768; idx += nthr) { const int b = idx >> 14, j = (idx >> 7) & 127, cc = idx & 127; const size_t r = (size_t)(b * SEQ + SEQ - 128 + j) * 256;
        p.out[O_PCK + idx] = bf2f(KV[r + cc]); p.out[O_PCV + idx] = bf2f(KV[r + 128 + cc]); }
    for (int idx = gtid; idx < 589824; idx += nthr) { const int b = idx / 4608, i = (idx % 4608) / 1536, ch = idx % 1536;
        p.out[O_SSC + idx] = i < 2 ? p.in[2][(size_t)(b * 3 + i + 1) * 1536 + ch] : bf2f(QG[(size_t)(MP + b) * 1536 + ch]); }
}

DI void norm_rows_mid(const Params& p, int gw, int NGW, int lane) {
    asm volatile("" : "+v"(lane));
    unsigned char* ws = p.ws; const bf16* T1 = (const bf16*)(ws + WS_T1); bf16* XN = (bf16*)(ws + WS_XN); bf16* X1B = (bf16*)(ws + WS_MIX);
    f32x4 g1[4], g2[4];
#pragma unroll
    for (int j = 0; j < 4; ++j) { g1[j] = *(const f32x4*)(p.in[14] + 4 * lane + 256 * j); g2[j] = *(const f32x4*)(p.in[15] + 4 * lane + 256 * j); }
    f32x4 nt[4], nxx[4];
    { const int m0 = gw < MR ? gw : 0; const float* xr0 = m0 < MP ? p.in[0] + (size_t)m0 * D : p.in[1] + (size_t)(m0 - MP) * D;
#pragma unroll
      for (int j = 0; j < 4; ++j) { { const u32x2 tb = *(const u32x2*)(T1 + (size_t)m0 * D + 4 * lane + 256 * j); nt[j] = (f32x4){bflo(tb.x), bfhi(tb.x), bflo(tb.y), bfhi(tb.y)}; } nxx[j] = *(const f32x4*)(xr0 + 4 * lane + 256 * j); } }
    for (int m = gw; m < MR; m += NGW) {
        f32x4 t[4], x[4]; float s = 0.f;
#pragma unroll
        for (int j = 0; j < 4; ++j) { t[j] = nt[j]; x[j] = nxx[j]; s += (t[j][0] * t[j][0] + t[j][1] * t[j][1]) + (t[j][2] * t[j][2] + t[j][3] * t[j][3]); }
        { const int mn = (m + NGW < MR) ? m + NGW : m; const float* xrn = mn < MP ? p.in[0] + (size_t)mn * D : p.in[1] + (size_t)(mn - MP) * D;
#pragma unroll
          for (int j = 0; j < 4; ++j) { { const u32x2 tb = *(const u32x2*)(T1 + (size_t)mn * D + 4 * lane + 256 * j); nt[j] = (f32x4){bflo(tb.x), bfhi(tb.x), bflo(tb.y), bfhi(tb.y)}; } nxx[j] = *(const f32x4*)(xrn + 4 * lane + 256 * j); } }
        const float rstd = 1.f / sqrtf(wave_sum(s) * (1.f / D) + EPS); float s2 = 0.f;
#pragma unroll
        for (int j = 0; j < 4; ++j) { x[j] = x[j] + t[j] * rstd * g1[j]; *(u32x2*)(X1B + (size_t)m * D + 4 * lane + 256 * j) = pk4(x[j]); s2 += (x[j][0] * x[j][0] + x[j][1] * x[j][1]) + (x[j][2] * x[j][2] + x[j][3] * x[j][3]); }
        const float rstd2 = 1.f / sqrtf(wave_sum(s2) * (1.f / D) + EPS);
#pragma unroll
        for (int j = 0; j < 4; ++j) *(u32x2*)(XN + (size_t)m * D + 4 * lane + 256 * j) = pk4(x[j] * rstd2 * g2[j]);
    }
}
DI void norm_rows_fin(const Params& p, int gw, int NGW, int lane) {
    asm volatile("" : "+v"(lane));
    const bf16* T2 = (const bf16*)(p.ws + WS_T2); const bf16* X1B = (const bf16*)(p.ws + WS_MIX);
    f32x4 g1[4];
#pragma unroll
    for (int j = 0; j < 4; ++j) g1[j] = *(const f32x4*)(p.in[18] + 4 * lane + 256 * j);
    f32x4 nt[4], nxx[4];
    { const int m0 = gw < MR ? gw : 0;
#pragma unroll
      for (int j = 0; j < 4; ++j) { { const u32x2 tb = *(const u32x2*)(T2 + (size_t)m0 * D + 4 * lane + 256 * j); nt[j] = (f32x4){bflo(tb.x), bfhi(tb.x), bflo(tb.y), bfhi(tb.y)}; } { const u32x2 xb = *(const u32x2*)(X1B + (size_t)m0 * D + 4 * lane + 256 * j); nxx[j] = (f32x4){bflo(xb.x), bfhi(xb.x), bflo(xb.y), bfhi(xb.y)}; } } }
    for (int m = gw; m < MR; m += NGW) {
        f32x4 t[4], x[4]; float s = 0.f;
#pragma unroll
        for (int j = 0; j < 4; ++j) { t[j] = nt[j]; x[j] = nxx[j]; s += (t[j][0] * t[j][0] + t[j][1] * t[j][1]) + (t[j][2] * t[j][2] + t[j][3] * t[j][3]); }
        { const int mn = (m + NGW < MR) ? m + NGW : m;
#pragma unroll
          for (int j = 0; j < 4; ++j) { { const u32x2 tb = *(const u32x2*)(T2 + (size_t)mn * D + 4 * lane + 256 * j); nt[j] = (f32x4){bflo(tb.x), bfhi(tb.x), bflo(tb.y), bfhi(tb.y)}; } { const u32x2 xb = *(const u32x2*)(X1B + (size_t)mn * D + 4 * lane + 256 * j); nxx[j] = (f32x4){bflo(xb.x), bfhi(xb.x), bflo(xb.y), bfhi(xb.y)}; } } }
        const float rstd = 1.f / sqrtf(wave_sum(s) * (1.f / D) + EPS);
#pragma unroll
        for (int j = 0; j < 4; ++j) *(f32x4*)(p.out + (size_t)m * D + 4 * lane + 256 * j) = x[j] + t[j] * rstd * g1[j];
    }
}

#define XB_TMO      128
#define XB_XCNT(j)  (256  + 64 * (j))
#define XB_XSUB(j)  (1280 + 64 * (j))
#define XB_XGEN(j)  (2304 + 64 * (j))
#define XB_TOP      3328
#define XB_TOPGEN   3392
#define XCD_BAR_WORDS 3456
#define XB_SPIN_CAP (1u << 18)

__device__ __forceinline__ unsigned xb_ld(unsigned* p)              { return __hip_atomic_load(p, __ATOMIC_RELAXED, __HIP_MEMORY_SCOPE_AGENT); }
__device__ __forceinline__ unsigned xb_add(unsigned* p, unsigned v) { return __hip_atomic_fetch_add(p, v, __ATOMIC_RELAXED, __HIP_MEMORY_SCOPE_AGENT); }
__device__ __forceinline__ unsigned xb_xcc_id() { return (unsigned)__builtin_amdgcn_s_getreg((3 << 11) | 20) & 0xFu; }
#define XB_SPIN(cond, bar) do { unsigned _sp = 0; while (cond) { __builtin_amdgcn_s_sleep(1); \
    if ((++_sp & 255u) == 0u) { if (xb_ld(&(bar)[XB_TMO])) break; if (_sp > XB_SPIN_CAP) { atomicAdd(&(bar)[XB_TMO], 1u); break; } } } } while (0)

struct XcdBarrier {
    unsigned* bar; unsigned x;
    volatile LAS unsigned* st;
};

__device__ __forceinline__ XcdBarrier xcd_barrier_post(unsigned* bar, volatile LAS unsigned* st) {
    XcdBarrier b; b.bar = bar; b.x = xb_xcc_id(); b.st = st;
    if (threadIdx.x == 0) (void)xb_add(&bar[XB_XCNT(b.x)], 1u);
    return b;
}
__device__ __forceinline__ void xcd_barrier_complete(unsigned* bar, unsigned x, unsigned& nloc, unsigned& nx) {
    const unsigned G = gridDim.x * gridDim.y * gridDim.z;
    unsigned sum, cnt, mine, sp = 0u;
    for (;;) {
        sum = 0u; cnt = 0u; mine = 0u;
#pragma unroll
        for (unsigned j = 0; j < 16; ++j) { const unsigned c = xb_ld(&bar[XB_XCNT(j)]); sum += c; cnt += (c > 0u) ? 1u : 0u; mine = (j == x) ? c : mine; }
        if (sum == G) break;
        __builtin_amdgcn_s_sleep(1);
        if ((++sp & 255u) == 0u) { if (xb_ld(&bar[XB_TMO])) break; if (sp > XB_SPIN_CAP) { atomicAdd(&bar[XB_TMO], 1u); break; } }
    }
    nloc = mine > 0u ? mine : 1u; nx = cnt > 0u ? cnt : 1u;
}

__device__ __forceinline__ void xcd_barrier(const XcdBarrier& b) {
    asm volatile("s_waitcnt vmcnt(0)" ::: "memory");
    __syncthreads();
    if (threadIdx.x == 0) {
        unsigned* bar = b.bar;
        __builtin_amdgcn_s_waitcnt(0);
        unsigned nloc = b.st[0], nx = b.st[1];
        if (nloc == 0u) { xcd_barrier_complete(bar, b.x, nloc, nx); b.st[0] = nloc; b.st[1] = nx; }
        const unsigned old = xb_add(&bar[XB_XSUB(b.x)], 1u);
        const unsigned gen = old / nloc;
        if (old + 1u == (gen + 1u) * nloc) {
            __builtin_amdgcn_fence(__ATOMIC_RELEASE, "agent");
            asm volatile("s_waitcnt vmcnt(0)" ::: "memory");
            const unsigned og = xb_add(&bar[XB_TOP], 1u);
            const unsigned tg = og / nx;
            if (og + 1u == (tg + 1u) * nx) xb_add(&bar[XB_TOPGEN], 1u);
            else XB_SPIN(xb_ld(&bar[XB_TOPGEN]) == tg, bar);
            __builtin_amdgcn_fence(__ATOMIC_ACQUIRE, "agent");
            xb_add(&bar[XB_XGEN(b.x)], 1u);
            asm volatile("s_waitcnt vmcnt(0)" ::: "memory");
        } else {
            XB_SPIN(xb_ld(&bar[XB_XGEN(b.x)]) == gen, bar);
            __builtin_amdgcn_fence(__ATOMIC_ACQUIRE, "agent");
            asm volatile("s_waitcnt vmcnt(0)" ::: "memory");
        }
    }
    __syncthreads();
}

struct StoreF32 { float* O; int ldc; DI void operator()(int r, int c, float v) const { O[(size_t)r * ldc + c] = v; } };
struct StoreBf16 { bf16* O; int ldc; DI void operator()(int r, int c, float v) const { O[(size_t)r * ldc + c] = (bf16)(pk2(v, 0.f) & 0xffffu); } };
struct StoreRelu2 { bf16* O; int ldc; DI void operator()(int r, int c, float v) const { const float a = fmaxf(v, 0.f); O[(size_t)r * ldc + c] = (bf16)(pk2(a * a, 0.f) & 0xffffu); } };
template <int TMT, int TNT, class Store>
DI void small_gemm_tile(const bf16* A, const bf16* Bt, int K, int row0, int col0, LAS float* part, int tid, int wid, int lane, const Store& st) {
    asm volatile("" : "+v"(tid), "+v"(lane));
    const int fr = lane & 15, fq = lane >> 4, ks = K >> 3;
    f32x4 acc[TMT][TNT];
#pragma unroll
    for (int m = 0; m < TMT; ++m)
#pragma unroll
        for (int n = 0; n < TNT; ++n) acc[m][n] = (f32x4){0.f, 0.f, 0.f, 0.f};
    const bf16* ap = A + (size_t)(row0 + fr) * K + wid * ks + 8 * fq;
    const bf16* bp = Bt + (size_t)(col0 + fr) * K + wid * ks + 8 * fq;
#pragma unroll 4
    for (int k = 0; k < ks; k += 32) {
        bf16x8 a[TMT], b[TNT];
#pragma unroll
        for (int m = 0; m < TMT; ++m) a[m] = *(const bf16x8*)(ap + (size_t)m * 16 * K + k);
#pragma unroll
        for (int n = 0; n < TNT; ++n) b[n] = *(const bf16x8*)(bp + (size_t)n * 16 * K + k);
#pragma unroll
        for (int m = 0; m < TMT; ++m)
#pragma unroll
            for (int n = 0; n < TNT; ++n) acc[m][n] = MFMA16(a[m], b[n], acc[m][n]);
    }
    constexpr int TM = TMT * 16, TN = TNT * 16;
#pragma unroll
    for (int m = 0; m < TMT; ++m)
#pragma unroll
        for (int n = 0; n < TNT; ++n)
#pragma unroll
            for (int i = 0; i < 4; ++i) part[(wid * TM + m * 16 + 4 * fq + i) * TN + n * 16 + fr] = acc[m][n][i];
    __syncthreads();
    for (int idx = tid; idx < TM * TN; idx += 512) { const int r = idx / TN, c = idx % TN; float v = 0.f;
#pragma unroll
        for (int w = 0; w < 8; ++w) v += part[(w * TM + r) * TN + c];
        st(row0 + r, col0 + c, v); }
    __syncthreads();
}

__global__ void __launch_bounds__(512, 2) fwd_megakernel(Params p) {
    extern __shared__ __attribute__((aligned(16))) unsigned char lds_raw[];
    LAS unsigned char* lds = (LAS unsigned char*)lds_raw;
    cg::grid_group grid = cg::this_grid();
    const int wid = __builtin_amdgcn_readfirstlane(threadIdx.x >> 6);
#define FRESH int tid = threadIdx.x; asm volatile("" : "+v"(tid)); int lane = tid & 63; (void)lane
    const int G = gridDim.x, bx = blockIdx.x;
    if (threadIdx.x < 16) ((LAS unsigned*)(lds + LDS_CTL))[threadIdx.x] = 0u;
    __syncthreads();
    XcdBarrier xbar = xcd_barrier_post((unsigned*)(p.ws + WS_BAR), (volatile LAS unsigned*)(lds + LDS_CTL));
#define GSYNC() do { if (p.use_cg) grid.sync(); else xcd_barrier(xbar); } while (0)
    const int gw = bx * 8 + wid, NGW = G * 8;
    unsigned char* ws = p.ws;
#ifndef PHM
#define PHM 0xFFFF
#endif
    { FRESH; if (PHM & 1) p0_prologue(p, lds, gw, NGW, wid, lane); }
    GSYNC();
    if (PHM & 2) { pg8::Gemm g{(const pg8::bf16_t*)(ws + WS_XN), (const pg8::bf16_t*)(ws + WS_WIN), MPAD, NIN, D}; pg8::StaticOrder S; S.init(MPAD, NIN, G, bx);
      pg8::EpiInProj E{(pg8::bf16_t*)(ws + WS_QA), (pg8::bf16_t*)(ws + WS_KV), (pg8::bf16_t*)(ws + WS_QG), (pg8::bf16_t*)(ws + WS_Z)};
      pg8::gemm_phase<pg8::EpiInProj, pg8::StaticOrder, true, true>(lds, g, S, E); }
    { FRESH; const int nfull = (MPAD / 256) * (NIN / 256) % G;
      if (nfull != 0 && bx >= nfull) late_transposes(p, lds, (bx - nfull) * 8 + wid, (G - nfull) * 8, wid, lane);
      else if (nfull == 0) late_transposes(p, lds, gw, NGW, wid, lane); }
    GSYNC();
    { FRESH; if ((G & 7) == 0) { const int per = G >> 3;
          for (int n = bx >> 3; n < 64; n += per) { if (PHM & 4) gdn_prep_unit(p, lds, (bx & 7) * 128 + n, tid, wid, lane); } }
      else for (int u = bx; u < 512; u += G) { if (PHM & 4) gdn_prep_unit(p, lds, (u >> 6) * 128 + (u & 63), tid, wid, lane); } }
    { FRESH; state_copies(p, bx * 512 + tid, G * 512); }
    GSYNC();
    { FRESH; if (bx < 64) { if (PHM & 32) scan_phase<0>(p, lds, bx, wid, lane); }
    else if ((G & 7) == 0) { const int per = (G - 64) >> 3;
        for (int n = (bx - 64) >> 3; n < 64; n += per) { if (PHM & 4) gdn_prep_unit(p, lds, (bx & 7) * 128 + 64 + n, tid, wid, lane); } }
    else for (int u = bx - 64; u < 512; u += G - 64) { if (PHM & 4) gdn_prep_unit(p, lds, (u >> 6) * 128 + 64 + (u & 63), tid, wid, lane); } }
    GSYNC();
    { FRESH; if (bx < 64) { if (PHM & 32) scan_phase<1>(p, lds, bx, wid, lane); }
    else for (int u = bx - 64; u < 896; u += G - 64) {
        if (u < 256) { if (PHM & 64) attn_unit(p, lds, u, tid, wid, lane); }
        else if (u < 768) { if (PHM & 8) sample_gdn_unit(p, lds, u - 256, tid, wid, lane); }
        else { if (PHM & 16) sample_attn_unit(p, lds, u - 768, tid, wid, lane); } } }
    GSYNC();
    { FRESH; if ((G & 7) == 0) { const int per = G >> 3;
          for (int j = bx >> 3; j < 64; j += per) { if (PHM & 128) gdn_out_pair(p, (bx & 7) * 64 + j, wid, lane); } }
      else for (int u = bx; u < 512; u += G) { if (PHM & 128) gdn_out_pair(p, u, wid, lane); } }
    GSYNC();
    if (PHM & 256) { pg8::Gemm g{(const pg8::bf16_t*)(ws + WS_MIX), (const pg8::bf16_t*)(ws + WS_WOUT), MP, D, D}; pg8::StaticOrder S; S.init(MP, D, G, bx);
      pg8::EpiBf16p E{(pg8::bf16_t*)(ws + WS_T1), D};
      pg8::gemm_phase<pg8::EpiBf16p, pg8::StaticOrder, true, true>(lds, g, S, E); }
    { FRESH; for (int t = bx; t < 256; t += G) small_gemm_tile<1, 2>((const bf16*)(ws + WS_MIX), (const bf16*)(ws + WS_WOUT), D, MP + (t >> 5) * 16, (t & 31) * 32, (LAS float*)lds, tid, wid, lane, StoreBf16{(bf16*)(ws + WS_T1), D}); }
    GSYNC();
    { FRESH; if (PHM & 512) norm_rows_mid(p, gw, NGW, lane); }
    GSYNC();
    if (PHM & 1024) { pg8::Gemm g{(const pg8::bf16_t*)(ws + WS_XN), (const pg8::bf16_t*)(ws + WS_WUP), MP, FF, D}; pg8::StaticOrder S; S.init(MP, FF, G, bx);
      pg8::EpiRelu2 E{(pg8::bf16_t*)(ws + WS_H), FF};
      pg8::gemm_phase<pg8::EpiRelu2, pg8::StaticOrder, true, true>(lds, g, S, E); }
    { FRESH; for (int t = bx; t < 256; t += G) small_gemm_tile<2, 4>((const bf16*)(ws + WS_XN), (const bf16*)(ws + WS_WUP), D, MP + (t >> 6) * 32, (t & 63) * 64, (LAS float*)lds, tid, wid, lane, StoreRelu2{(bf16*)(ws + WS_H), FF}); }
    GSYNC();
    if (PHM & 2048) { pg8::Gemm g{(const pg8::bf16_t*)(ws + WS_H), (const pg8::bf16_t*)(ws + WS_WDN), MP, D, FF}; pg8::StaticOrder S; S.init(MP, D, G, bx);
      pg8::EpiBf16p E{(pg8::bf16_t*)(ws + WS_T2), D};
      pg8::gemm_phase<pg8::EpiBf16p, pg8::StaticOrder, true, true>(lds, g, S, E); }
    { FRESH; for (int t = bx; t < 256; t += G) small_gemm_tile<1, 2>((const bf16*)(ws + WS_H), (const bf16*)(ws + WS_WDN), FF, MP + (t >> 5) * 16, (t & 31) * 32, (LAS float*)lds, tid, wid, lane, StoreBf16{(bf16*)(ws + WS_T2), D}); }
    GSYNC();
    { FRESH; if (PHM & 4096) norm_rows_fin(p, gw, NGW, lane); }
}

extern "C" void kernel_launch(void* const* d_in, const int* in_sizes, int n_in, void* d_out, int out_size, void* d_ws, size_t ws_size, hipStream_t stream) {
    static int grid = 0;
    if (grid == 0) {
        if (n_in != 19 || ws_size < WS_END) { fprintf(stderr, "kernel_launch: unexpected n_in %d / ws_size %zu\n", n_in, ws_size); grid = -1; return; }
        int dev = 0, cus = 0, per_cu = 0;
        hipGetDevice(&dev); hipDeviceGetAttribute(&cus, hipDeviceAttributeMultiprocessorCount, dev);
        if (hipFuncSetAttribute((const void*)fwd_megakernel, hipFuncAttributeMaxDynamicSharedMemorySize, LDS_BYTES) != hipSuccess) { fprintf(stderr, "kernel_launch: hipFuncSetAttribute failed\n"); }
        hipOccupancyMaxActiveBlocksPerMultiprocessor(&per_cu, (const void*)fwd_megakernel, 512, LDS_BYTES);
        (void)hipGetLastError();
        if (per_cu < 1) { fprintf(stderr, "kernel_launch: occupancy query says %d blocks/CU\n", per_cu); per_cu = 1; }
        grid = cus;
        if (grid < 65) { fprintf(stderr, "kernel_launch: grid %d too small\n", grid); grid = -1; return; }
    }
    if (grid < 0) return;
    Params p{};
    for (int i = 0; i < 19; ++i) p.in[i] = (const float*)d_in[i];
    p.out = (float*)d_out; p.ws = (unsigned char*)d_ws; p.use_cg = 0; p.pad = 0;
    (void)hipMemsetAsync((unsigned char*)d_ws + WS_BAR, 0, 16384, stream);
    void* args[] = {&p};
    hipError_t e = hipLaunchCooperativeKernel((const void*)fwd_megakernel, dim3(grid), dim3(512), args, LDS_BYTES, stream);
    if (e != hipSuccess) fprintf(stderr, "cooperative launch failed: %s (grid %d)\n", hipGetErrorString(e), grid);
}
```
